# Optimizing an MI355X kernel written in HIP

```python
import math
import jax, jax.numpy as jnp
from jax import lax
import numpy as np

D_MODEL = 1024
BATCH = 8
SEQ = 2048
DEPTH = 1
DEC_BATCH = 16
DEC_SEQ = 32
PAST_LEN = 2048

CHUNK = 64
D_MIX = D_MODEL
ATT_HEAD_DIM = 64
D_ATT = D_MIX // 2
N_ATT_HEADS = D_ATT // ATT_HEAD_DIM
D_SSM = D_MIX - D_ATT
SSM_HEAD_DIM = 64
N_SSM_HEADS = D_SSM // SSM_HEAD_DIM
SSM_GROUPS = 2
SSM_HEADS_PER_GROUP = N_SSM_HEADS // SSM_GROUPS
SSM_STATE = 64
SSM_CONV = 4
SSM_CHUNK = CHUNK
CONV_DIM = D_SSM + 2 * SSM_GROUPS * SSM_STATE
D_FF = 2816
FFN_CONV = 3
Q_BLOCK = 128
D_IN_PROJ = 3 * D_ATT + D_SSM + CONV_DIM + N_SSM_HEADS
NORM_EPS = 1e-6

kernel_name = 'hybrid_stickbreak_ssd_convffn_stream_step'


def rmsnorm(x, g):
    x32 = x.astype(jnp.float32)
    y = x32 * lax.rsqrt(jnp.mean(x32 * x32, axis=-1, keepdims=True) + NORM_EPS)
    return (y * g.astype(jnp.float32)).astype(x.dtype)


def causal_dwconv(x, prev, w, bias):
    K = w.shape[0]
    l = x.shape[1]
    xp = jnp.concatenate([prev.astype(x.dtype), x], axis=1)
    out = bias.astype(x.dtype)
    for i in range(K):
        out = out + xp[:, i:i + l] * w[i].astype(x.dtype)
    return out, xp[:, l:]


def _stick_breaking_block(q, q_pos, k, v, k_pos):
    z = jnp.einsum('bqhd,bkhd->bhqk', q, k).astype(jnp.float32) * (ATT_HEAD_DIM ** -0.5)
    causal = k_pos[None, :] < q_pos[:, None]
    log_keep = jnp.where(causal, jax.nn.log_sigmoid(-z), 0.0)
    log_after = lax.cumsum(log_keep, axis=3, reverse=True) - log_keep
    w = jnp.where(causal, jnp.exp(jax.nn.log_sigmoid(z) + log_after), 0.0)
    return jnp.einsum('bhqk,bkhd->bqhd', w.astype(v.dtype), v)


def stick_breaking(q, q_pos, k, v, k_pos):
    b, l, h, d = q.shape
    if l > Q_BLOCK and l % Q_BLOCK == 0:
        nb = l // Q_BLOCK
        qb = q.reshape(b, nb, Q_BLOCK, h, d).transpose(1, 0, 2, 3, 4)
        pb = q_pos.reshape(nb, Q_BLOCK)
        ob = lax.map(lambda a: _stick_breaking_block(a[0], a[1], k, v, k_pos), (qb, pb))
        return ob.transpose(1, 0, 2, 3, 4).reshape(b, l, h, d)
    return _stick_breaking_block(q, q_pos, k, v, k_pos)


def ssd_scan(x, dt, a, bmat, cmat, h0):
    bsz, l = x.shape[0], x.shape[1]
    q = min(SSM_CHUNK, l)
    c = l // q
    G, R, P, N = SSM_GROUPS, SSM_HEADS_PER_GROUP, SSM_HEAD_DIM, SSM_STATE
    xs = x.reshape(bsz, c, q, G, R, P)
    dts = dt.reshape(bsz, c, q, G, R)
    bs = bmat.reshape(bsz, c, q, G, N)
    cs = cmat.reshape(bsz, c, q, G, N)
    acum = jnp.cumsum(dts * a.reshape(G, R), axis=2)
    seg = acum[:, :, :, None] - acum[:, :, None]
    tri = jnp.tril(jnp.ones((q, q), dtype=bool))[:, :, None, None]
    decay = jnp.exp(jnp.where(tri, seg, -jnp.inf))
    cb = jnp.einsum('bctgn,bcsgn->bctsg', cs, bs)
    y_diag = jnp.einsum('bctsg,bctsgr,bcsgr,bcsgrp->bctgrp', cb, decay, dts, xs)
    to_end = jnp.exp(acum[:, :, -1:] - acum)
    chunk_states = jnp.einsum('bcsgn,bcsgr,bcsgrp->bcgrpn', bs, to_end * dts, xs)
    chunk_decay = jnp.exp(acum[:, :, -1])

    def step(h, inp):
        st, dec = inp
        return dec[..., None, None] * h + st, h

    h_final, h_in = lax.scan(step, h0.reshape(bsz, G, R, P, N),
                             (jnp.moveaxis(chunk_states, 1, 0), jnp.moveaxis(chunk_decay, 1, 0)))
    h_in = jnp.moveaxis(h_in, 0, 1)
    y_off = jnp.einsum('bctgn,bctgr,bcgrpn->bctgrp', cs, jnp.exp(acum), h_in)
    y = (y_diag + y_off).reshape(bsz, l, N_SSM_HEADS, P)
    return y, h_final.reshape(bsz, N_SSM_HEADS, P, N)


def mixer(h, k_past, v_past, ssm_h0, conv_prev, p):
    b, l, _ = h.shape
    proj = h @ p['w_in']
    o = 0
    q = proj[..., o:o + D_ATT].reshape(b, l, N_ATT_HEADS, ATT_HEAD_DIM); o += D_ATT
    k = proj[..., o:o + D_ATT].reshape(b, l, N_ATT_HEADS, ATT_HEAD_DIM); o += D_ATT
    v = proj[..., o:o + D_ATT].reshape(b, l, N_ATT_HEADS, ATT_HEAD_DIM); o += D_ATT
    z = proj[..., o:o + D_SSM]; o += D_SSM
    xbc = proj[..., o:o + CONV_DIM]; o += CONV_DIM
    dt_raw = proj[..., o:o + N_SSM_HEADS]

    past = k_past.shape[1]
    k_all = jnp.concatenate([k_past.astype(k.dtype), k], axis=1)
    v_all = jnp.concatenate([v_past.astype(v.dtype), v], axis=1)
    q_pos = past + jnp.arange(l)
    k_pos = jnp.arange(past + l)
    attn = stick_breaking(q, q_pos, k_all, v_all, k_pos).reshape(b, l, D_ATT)

    xbc_c, conv_new = causal_dwconv(xbc, conv_prev, p['ssm_conv_w'], p['ssm_conv_b'])
    xbc_c = jax.nn.silu(xbc_c)
    gn = SSM_GROUPS * SSM_STATE
    xh = xbc_c[..., :D_SSM].reshape(b, l, N_SSM_HEADS, SSM_HEAD_DIM).astype(jnp.float32)
    bm = xbc_c[..., D_SSM:D_SSM + gn].reshape(b, l, SSM_GROUPS, SSM_STATE).astype(jnp.float32)
    cm = xbc_c[..., D_SSM + gn:].reshape(b, l, SSM_GROUPS, SSM_STATE).astype(jnp.float32)
    dt = jax.nn.softplus(dt_raw.astype(jnp.float32) + p['dt_bias'].astype(jnp.float32))
    a = -jnp.exp(p['a_log'].astype(jnp.float32))
    y, h_fin = ssd_scan(xh, dt, a, bm, cm, ssm_h0.astype(jnp.float32))
    y = y + p['d_skip'].astype(jnp.float32)[:, None] * xh
    y = y.reshape(b, l, D_SSM).astype(h.dtype)
    y = rmsnorm(y * jax.nn.silu(z), p['g_ssm_out'])

    out = jnp.concatenate([rmsnorm(attn, p['g_attn_out']), y], axis=-1) @ p['w_out']
    return out, k, v, h_fin.astype(ssm_h0.dtype), conv_new


def conv_ffn(h, conv_prev, p):
    gu = h @ p['w_up']
    gate, up = gu[..., :D_FF], gu[..., D_FF:]
    gate_c, conv_new = causal_dwconv(gate, conv_prev, p['ffn_conv_w'], p['ffn_conv_b'])
    act = jax.nn.gelu(gate_c, approximate=True) * up
    return act @ p['w_down'], conv_new


def layer(x, k_past, v_past, ssm_h0, ssm_conv_prev, ffn_conv_prev, p):
    m, k, v, h_fin, ssm_conv_new = mixer(rmsnorm(x, p['g_mix_pre']), k_past, v_past, ssm_h0, ssm_conv_prev, p)
    x = x + rmsnorm(m, p['g_mix_post'])
    f, ffn_conv_new = conv_ffn(rmsnorm(x, p['g_ffn_pre']), ffn_conv_prev, p)
    x = x + rmsnorm(f, p['g_ffn_post'])
    return x, k, v, h_fin, ssm_conv_new, ffn_conv_new


def setup_inputs(seed: int = 0) -> dict:
    key = jax.random.key(seed)
    ks = jax.random.split(key, 24)
    f32 = jnp.float32

    def nrm(k, shape, scale):
        return jax.random.normal(k, shape, f32) * scale

    def gain(k, shape):
        return 1.0 + 0.05 * jax.random.normal(k, shape, f32)

    dt0 = jnp.exp(jax.random.uniform(ks[12], (DEPTH, N_SSM_HEADS), f32)
                  * (math.log(0.1) - math.log(0.001)) + math.log(0.001))
    dt_bias = dt0 + jnp.log(-jnp.expm1(-dt0))
    a_log = jnp.log(jax.random.uniform(ks[13], (DEPTH, N_SSM_HEADS), f32, minval=1.0, maxval=16.0))
    return {
        'x_prompt': nrm(ks[0], (BATCH, SEQ, D_MODEL), 1.0),
        'x_sample': nrm(ks[1], (DEC_BATCH, DEC_SEQ, D_MODEL), 1.0),
        'cache_k': nrm(ks[2], (DEPTH, DEC_BATCH, PAST_LEN, N_ATT_HEADS, ATT_HEAD_DIM), 1.0),
        'cache_v': nrm(ks[3], (DEPTH, DEC_BATCH, PAST_LEN, N_ATT_HEADS, ATT_HEAD_DIM), 1.0),
        'state_ssm': nrm(ks[4], (DEPTH, DEC_BATCH, N_SSM_HEADS, SSM_HEAD_DIM, SSM_STATE), 0.1),
        'state_ssm_conv': nrm(ks[5], (DEPTH, DEC_BATCH, SSM_CONV - 1, CONV_DIM), 1.0),
        'state_ffn_conv': nrm(ks[6], (DEPTH, DEC_BATCH, FFN_CONV - 1, D_FF), 1.0),
        'g_mix_pre': gain(ks[7], (DEPTH, D_MODEL)),
        'g_mix_post': gain(ks[8], (DEPTH, D_MODEL)),
        'w_in': nrm(ks[9], (DEPTH, D_MODEL, D_IN_PROJ), D_MODEL ** -0.5),
        'ssm_conv_w': nrm(ks[10], (DEPTH, SSM_CONV, CONV_DIM), SSM_CONV ** -0.5),
        'ssm_conv_b': nrm(ks[11], (DEPTH, CONV_DIM), 0.02),
        'dt_bias': dt_bias,
        'a_log': a_log,
        'd_skip': 1.0 + 0.1 * jax.random.normal(ks[14], (DEPTH, N_SSM_HEADS), f32),
        'g_ssm_out': gain(ks[15], (DEPTH, D_SSM)),
        'g_attn_out': gain(ks[16], (DEPTH, D_ATT)),
        'w_out': nrm(ks[17], (DEPTH, D_MIX, D_MODEL), D_MIX ** -0.5),
        'g_ffn_pre': gain(ks[18], (DEPTH, D_MODEL)),
        'g_ffn_post': gain(ks[19], (DEPTH, D_MODEL)),
        'w_up': nrm(ks[20], (DEPTH, D_MODEL, 2 * D_FF), D_MODEL ** -0.5),
        'ffn_conv_w': nrm(ks[21], (DEPTH, FFN_CONV, D_FF), FFN_CONV ** -0.5),
        'ffn_conv_b': nrm(ks[22], (DEPTH, D_FF), 0.02),
        'w_down': nrm(ks[23], (DEPTH, D_FF, D_MODEL), D_FF ** -0.5),
    }


def reference(x_prompt, x_sample, cache_k, cache_v, state_ssm, state_ssm_conv, state_ffn_conv,
              g_mix_pre, g_mix_post, w_in, ssm_conv_w, ssm_conv_b, dt_bias, a_log, d_skip,
              g_ssm_out, g_attn_out, w_out, g_ffn_pre, g_ffn_post, w_up, ffn_conv_w, ffn_conv_b, w_down):
    bp = x_prompt.shape[0]
    dtp = x_prompt.dtype
    zk = jnp.zeros((bp, 0, N_ATT_HEADS, ATT_HEAD_DIM), dtp)
    zh = jnp.zeros((bp, N_SSM_HEADS, SSM_HEAD_DIM, SSM_STATE), dtp)
    zcs = jnp.zeros((bp, SSM_CONV - 1, CONV_DIM), dtp)
    zcf = jnp.zeros((bp, FFN_CONV - 1, D_FF), dtp)

    y_p, y_s = x_prompt, x_sample
    kp_l, vp_l, hp_l, csp_l, cfp_l = [], [], [], [], []
    ks_l, vs_l, hs_l, css_l, cfs_l = [], [], [], [], []
    for i in range(DEPTH):
        p = {
            'g_mix_pre': g_mix_pre[i], 'g_mix_post': g_mix_post[i], 'w_in': w_in[i],
            'ssm_conv_w': ssm_conv_w[i], 'ssm_conv_b': ssm_conv_b[i], 'dt_bias': dt_bias[i],
            'a_log': a_log[i], 'd_skip': d_skip[i], 'g_ssm_out': g_ssm_out[i],
            'g_attn_out': g_attn_out[i], 'w_out': w_out[i], 'g_ffn_pre': g_ffn_pre[i],
            'g_ffn_post': g_ffn_post[i], 'w_up': w_up[i], 'ffn_conv_w': ffn_conv_w[i],
            'ffn_conv_b': ffn_conv_b[i], 'w_down': w_down[i],
        }
        y_p, kp, vp, hp, csp, cfp = layer(y_p, zk, zk, zh, zcs, zcf, p)
        y_s, kn, vn, hn, csn, cfn = layer(y_s, cache_k[i], cache_v[i], state_ssm[i],
                                          state_ssm_conv[i], state_ffn_conv[i], p)
        kp_l.append(kp); vp_l.append(vp); hp_l.append(hp); csp_l.append(csp); cfp_l.append(cfp)
        ks_l.append(kn); vs_l.append(vn); hs_l.append(hn); css_l.append(csn); cfs_l.append(cfn)

    return (y_p, y_s,
            jnp.stack(kp_l), jnp.stack(vp_l), jnp.stack(hp_l), jnp.stack(csp_l), jnp.stack(cfp_l),
            jnp.stack(ks_l), jnp.stack(vs_l), jnp.stack(hs_l), jnp.stack(css_l), jnp.stack(cfs_l))
```

```cpp
#include <hip/hip_runtime.h>
#include <hip/hip_cooperative_groups.h>
#include <cstdio>
#include <cstdint>
namespace cg = cooperative_groups;
namespace pg8 {
#define PG8_LAS __attribute__((address_space(3)))
typedef unsigned short bf16_t;
typedef short bf16x8 __attribute__((ext_vector_type(8)));
typedef float f32x4 __attribute__((ext_vector_type(4)));
typedef unsigned u32x4 __attribute__((ext_vector_type(4)));
constexpr int BM = 256, BK = 64, HALF = 128, HTB = HALF * BK * 2  , STAGE_BYTES = 8 * HTB, NXCD = 8, WGM = 8;

__host__ __device__ __forceinline__ int lds_byte(int r, int c) { const int st = (r >> 4) * 2 + (c >> 5), rr = r & 15, cc = c & 31, ob = rr * 64 + cc * 2; return st * 1024 + (ob ^ (((ob >> 9) & 1) << 5)); }
__host__ __device__ __forceinline__ void stage_rc(int b, int& R, int& C) { const int st = b / 1024, sb = b % 1024, swz = sb ^ (((sb >> 9) & 1) << 5); R = (st >> 1) * 16 + swz / 64; C = (st & 1) * 32 + (swz % 64) / 2; }
__host__ __device__ __forceinline__ int perm32(int rho) { const int n = rho >> 4, i = rho & 15; return 8 * (i >> 2) + 4 * n + (i & 3); }

struct Unit { int pm, pn; };
struct Gemm { const bf16_t* A; const bf16_t* Bt; int M, N, K; };

struct StaticOrder {
    int nM, nN, nwg, G, c;
    __host__ __device__ void init(int M, int N, int G_, int c_) { nM = M / BM; nN = N / BM; nwg = nM * nN; G = G_; c = c_; }
    __host__ __device__ bool next(int i, Unit& u) const {
        const long L = (long)i * G + c; if (L >= nwg) return false;
        int wgid = (int)L; { const int q = nwg / NXCD, r = nwg % NXCD, xcd = wgid % NXCD, off = wgid / NXCD; wgid = (xcd < r ? xcd * (q + 1) : r * (q + 1) + (xcd - r) * q) + off; }
        const int nig = WGM * nN, gid = wgid / nig, fm = gid * WGM, gsz = (nM - fm) < WGM ? (nM - fm) : WGM;
        u.pm = fm + ((wgid % nig) % gsz); u.pn = (wgid % nig) / gsz; return true;
    }
    __device__ __forceinline__ void a_ready(const Unit&) const {}
    __device__ __forceinline__ void done(const Unit&) const {}
};
__device__ __forceinline__ unsigned cvt_pk_bf16(float lo, float hi) { unsigned r; asm volatile("v_cvt_pk_bf16_f32 %0, %1, %2" : "=v"(r) : "v"(lo), "v"(hi)); return r; }
template <class Epi, class Sched, bool ALIGN_EPI = false, bool SP2 = false>
__device__ __forceinline__ void gemm_phase(PG8_LAS unsigned char* lds, const Gemm g, const Sched& S, const Epi& E) {
    const int tid = threadIdx.x, wid = __builtin_amdgcn_readfirstlane(tid >> 6), lane = tid & 63, wr = wid >> 2, wc = wid & 3, fr = lane & 15, fq = lane >> 4;
    const int K = g.K, nt = K / BK;
    unsigned voffA[2], voffB[2];
#pragma unroll
    for (int i = 0; i < 2; ++i) { int R, C; stage_rc(tid * 16 + i * 8192, R, C); const int Rb = Epi::PERM ? ((R & ~31) + perm32(R & 31)) : R;
        voffA[i] = (unsigned)(R * K + C) * 2u; voffB[i] = (unsigned)(Rb * K + C) * 2u; }
    const size_t kstep = (size_t)(BK * 2);
    const size_t hstep = (size_t)HALF * K * 2;
    const size_t tstep = 2 * hstep;
    const unsigned ldsw = (unsigned)wid * 1024u;
    const int aoff = lds_byte(wr * 64 + fr, fq * 8), boff = lds_byte(wc * 32 + fr, fq * 8);
#define PG8_SA(b, h) (((b) * 2 + (h)) * HTB)
#define PG8_SB(b, h) ((4 + (b) * 2 + (h)) * HTB)
#define PG8_STAGE(bufoff, gbase, voff) do { _Pragma("unroll") for (int _i = 0; _i < 2; ++_i) \
        __builtin_amdgcn_global_load_lds((const unsigned*)((const char*)(gbase) + (voff)[_i]), (PG8_LAS unsigned*)(lds + (bufoff) + ldsw + _i * 8192), 16, 0, 0); } while (0)
#define PG8_LDA(dst, b, h) do { _Pragma("unroll") for (int m = 0; m < 4; ++m) _Pragma("unroll") for (int k = 0; k < 2; ++k) dst[m][k] = *(const PG8_LAS bf16x8*)(lds + PG8_SA(b, h) + aoff + m * 2048 + k * 1024); } while (0)
#define PG8_LDB(dst, b, h) do { _Pragma("unroll") for (int n = 0; n < 2; ++n) _Pragma("unroll") for (int k = 0; k < 2; ++k) dst[n][k] = *(const PG8_LAS bf16x8*)(lds + PG8_SB(b, h) + boff + n * 2048 + k * 1024); } while (0)
#define PG8_MMA(ai, bj, At, Bt) do { __builtin_amdgcn_s_setprio(1); _Pragma("unroll") for (int m = 0; m < 4; ++m) _Pragma("unroll") for (int n = 0; n < 2; ++n) _Pragma("unroll") for (int k = 0; k < 2; ++k) \
        acc[ai][bj][m][n] = __builtin_amdgcn_mfma_f32_16x16x32_bf16(Bt[n][k], At[m][k], acc[ai][bj][m][n], 0, 0, 0); __builtin_amdgcn_s_setprio(0); } while (0)
#define PG8_WAIT_V(n) asm volatile("s_waitcnt vmcnt(" #n ")" ::: "memory")
#define PG8_WAIT_L(n) asm volatile("s_waitcnt lgkmcnt(" #n ")" ::: "memory")
#define PG8_BAR __builtin_amdgcn_s_barrier()
#define PG8_SCHED __builtin_amdgcn_sched_barrier(0)
    Unit cur, nxt; int ui = 0;
    if (!S.next(0, cur)) return;
    f32x4 acc[2][2][4][2];
#pragma unroll
    for (int a = 0; a < 2; ++a)
#pragma unroll
        for (int b = 0; b < 2; ++b)
#pragma unroll
            for (int m = 0; m < 4; ++m)
#pragma unroll
                for (int n = 0; n < 2; ++n) acc[a][b][m][n] = (f32x4){0.f, 0.f, 0.f, 0.f};
    bf16x8 At[4][2], B0[2][2], B1[2][2];
    const char* cA = (const char*)g.A + (size_t)cur.pm * tstep; const char* cB = (const char*)g.Bt + (size_t)cur.pn * tstep;
    S.a_ready(cur);
    if constexpr (SP2) {
        PG8_STAGE(PG8_SB(0, 0), cB, voffB); PG8_STAGE(PG8_SB(0, 1), cB + hstep, voffB); PG8_STAGE(PG8_SA(0, 0), cA, voffA); PG8_STAGE(PG8_SA(0, 1), cA + hstep, voffA);
        if (wr == 1) PG8_BAR;
        PG8_WAIT_V(2); PG8_BAR;
        PG8_STAGE(PG8_SB(1, 0), cB + kstep, voffB); PG8_STAGE(PG8_SA(1, 0), cA + kstep, voffA); PG8_STAGE(PG8_SB(1, 1), cB + hstep + kstep, voffB);
        PG8_WAIT_V(6); PG8_BAR;
    } else {
        PG8_STAGE(PG8_SB(0, 0), cB, voffB); PG8_STAGE(PG8_SA(0, 0), cA, voffA); PG8_STAGE(PG8_SB(0, 1), cB + hstep, voffB); PG8_STAGE(PG8_SA(0, 1), cA + hstep, voffA);
        if (wr == 1) PG8_BAR;
        PG8_WAIT_V(4); PG8_BAR;
        PG8_STAGE(PG8_SB(1, 0), cB + kstep, voffB); PG8_STAGE(PG8_SA(1, 0), cA + kstep, voffA); PG8_STAGE(PG8_SB(1, 1), cB + hstep + kstep, voffB);
        PG8_WAIT_V(6); PG8_BAR;
    }
    for (;;) {
        const bool has_next = S.next(ui + 1, nxt);
        const char* nA = has_next ? (const char*)g.A + (size_t)nxt.pm * tstep : cA; const char* nB = has_next ? (const char*)g.Bt + (size_t)nxt.pn * tstep : cB;
        for (int t = 0; t < nt; t += 2) {
            const bool last = (t == nt - 2);
            const char* a1 = cA + (size_t)(t + 1) * kstep;
            const char* a2 = last ? nA : cA + (size_t)(t + 2) * kstep; const char* b2 = last ? nB : cB + (size_t)(t + 2) * kstep;
            const char* a3 = a2 + kstep; const char* b3 = b2 + kstep;
            if (last && has_next) S.a_ready(nxt);
            if constexpr (SP2) {
            PG8_LDB(B0, 0, 0); PG8_LDB(B1, 0, 1); PG8_SCHED; PG8_LDA(At, 0, 0); PG8_STAGE(PG8_SA(1, 1), a1 + hstep, voffA);
            PG8_WAIT_V(8); PG8_WAIT_L(0); PG8_BAR; PG8_MMA(0, 0, At, B0); PG8_MMA(0, 1, At, B1); PG8_BAR; PG8_SCHED;
            PG8_LDA(At, 0, 1); PG8_STAGE(PG8_SB(0, 0), b2, voffB); PG8_STAGE(PG8_SB(0, 1), b2 + hstep, voffB); PG8_STAGE(PG8_SA(0, 0), a2, voffA);
            PG8_WAIT_V(8); PG8_WAIT_L(0); PG8_BAR; PG8_MMA(1, 0, At, B0); PG8_MMA(1, 1, At, B1); PG8_BAR; PG8_SCHED;
            PG8_LDB(B0, 1, 0); PG8_LDB(B1, 1, 1); PG8_SCHED; PG8_LDA(At, 1, 0); PG8_STAGE(PG8_SA(0, 1), a2 + hstep, voffA);
            PG8_WAIT_V(8); PG8_WAIT_L(0); PG8_BAR; PG8_MMA(0, 0, At, B0); PG8_MMA(0, 1, At, B1); PG8_BAR; PG8_SCHED;
            PG8_LDA(At, 1, 1); PG8_STAGE(PG8_SB(1, 0), b3, voffB); PG8_STAGE(PG8_SB(1, 1), b3 + hstep, voffB); PG8_STAGE(PG8_SA(1, 0), a3, voffA);
            PG8_WAIT_V(8); PG8_WAIT_L(0); PG8_BAR; PG8_MMA(1, 0, At, B0); PG8_MMA(1, 1, At, B1); PG8_BAR; PG8_SCHED;
            } else {
            PG8_LDB(B0, 0, 0); PG8_SCHED; PG8_LDA(At, 0, 0); PG8_STAGE(PG8_SA(1, 1), a1 + hstep, voffA);
            PG8_WAIT_L(8); PG8_BAR; PG8_WAIT_L(0); PG8_MMA(0, 0, At, B0); PG8_BAR; PG8_SCHED;
            PG8_LDB(B1, 0, 1); PG8_STAGE(PG8_SB(0, 0), b2, voffB);
            PG8_BAR; PG8_WAIT_L(0); PG8_MMA(0, 1, At, B1); PG8_BAR;
            PG8_LDA(At, 0, 1); PG8_STAGE(PG8_SA(0, 0), a2, voffA);
            PG8_BAR; PG8_WAIT_L(0); PG8_MMA(1, 0, At, B0); PG8_BAR; PG8_SCHED;
            PG8_STAGE(PG8_SB(0, 1), b2 + hstep, voffB);
            PG8_WAIT_V(6); PG8_BAR; PG8_MMA(1, 1, At, B1); PG8_BAR;
            PG8_LDB(B0, 1, 0); PG8_SCHED; PG8_LDA(At, 1, 0); PG8_STAGE(PG8_SA(0, 1), a2 + hstep, voffA);
            PG8_WAIT_L(8); PG8_BAR; PG8_WAIT_L(0); PG8_MMA(0, 0, At, B0); PG8_BAR; PG8_SCHED;
            PG8_LDB(B1, 1, 1); PG8_STAGE(PG8_SB(1, 0), b3, voffB);
            PG8_BAR; PG8_WAIT_L(0); PG8_MMA(0, 1, At, B1); PG8_BAR;
            PG8_LDA(At, 1, 1); PG8_STAGE(PG8_SA(1, 0), a3, voffA);
            PG8_BAR; PG8_WAIT_L(0); PG8_MMA(1, 0, At, B0); PG8_BAR; PG8_SCHED;
            PG8_STAGE(PG8_SB(1, 1), b3 + hstep, voffB);
            PG8_WAIT_V(6); PG8_BAR; PG8_MMA(1, 1, At, B1); PG8_BAR;
            }
        }
        if constexpr (ALIGN_EPI) { if (wr == 0) PG8_BAR; }
        if constexpr (!Epi::AFTER_DRAIN) { E(acc, cur, wr, wc, fr, fq); S.done(cur); }
        if (!has_next) break;
#pragma unroll
        for (int a = 0; a < 2; ++a)
#pragma unroll
            for (int b = 0; b < 2; ++b)
#pragma unroll
                for (int m = 0; m < 4; ++m)
#pragma unroll
                    for (int n = 0; n < 2; ++n) acc[a][b][m][n] = (f32x4){0.f, 0.f, 0.f, 0.f};
        cur = nxt; cA = nA; cB = nB; ++ui;
        if constexpr (ALIGN_EPI) { if (wr == 1) PG8_BAR; }
    }
    PG8_WAIT_V(0);
    if constexpr (!ALIGN_EPI) { if (wr == 0) PG8_BAR; }
    PG8_BAR;
    if constexpr (Epi::AFTER_DRAIN) { E.fused(acc, cur, wr, wc, fr, fq, lds, wid, lane); S.done(cur); }
#undef PG8_SA
#undef PG8_SB
#undef PG8_STAGE
#undef PG8_LDA
#undef PG8_LDB
#undef PG8_MMA
#undef PG8_WAIT_V
#undef PG8_WAIT_L
#undef PG8_BAR
#undef PG8_SCHED
}
}

#define DI __device__ __forceinline__
#define LAS __attribute__((address_space(3)))
typedef unsigned short bf16;
typedef short bf16x8 __attribute__((ext_vector_type(8)));
typedef float f32x4 __attribute__((ext_vector_type(4)));
typedef float f32x16 __attribute__((ext_vector_type(16)));
typedef unsigned u32x4 __attribute__((ext_vector_type(4)));
typedef unsigned u32x2 __attribute__((ext_vector_type(2)));
typedef __bf16 bf16x2_t __attribute__((ext_vector_type(2)));
typedef float f32x2_t __attribute__((ext_vector_type(2)));

constexpr int DM = 1024, NBP = 8, LP = 2048, NBS = 16, LS = 32, PAST = 2048;
constexpr int MP = NBP * LP, MS = NBS * LS, MT = MP + MS;
constexpr int NPROJ = 2816, DIN = 2824, DFF = 2816, NUP = 5632;
constexpr int CONVD = 768, NH = 8;
constexpr float EPS = 1e-6f;
constexpr int NCH = LP / 64;

constexpr size_t O_YP = 0, O_YS = 16777216, O_KP = 17301504, O_VP = 25690112, O_HP = 34078720, O_CSP = 34340864, O_CFP = 34359296,
                 O_KS = 34404352, O_VS = 34666496, O_HS = 34928640, O_CSS = 35452928, O_CFS = 35489792, O_END = 35579904;

constexpr size_t MiB = 1u << 20;
constexpr size_t WS_WIN = 1 * MiB, WS_WOUT = 7 * MiB, WS_WUP = 9 * MiB, WS_WDN = 20 * MiB;
constexpr size_t WS_A16 = 26 * MiB;
constexpr size_t WS_G = 60 * MiB, WS_U = 151 * MiB;
constexpr size_t WS_Q = 60 * MiB, WS_K = 77 * MiB, WS_V = 94 * MiB, WS_Z = 111 * MiB;
constexpr size_t WS_XBC = 128 * MiB;
constexpr size_t WS_ST = 153 * MiB;
constexpr size_t WS_DEC = 185 * MiB;
constexpr size_t WS_DT = 186 * MiB;
constexpr size_t WS_M = 188 * MiB;
constexpr size_t WS_F = 60 * MiB;
constexpr size_t WS_NEED = 254 * MiB;

constexpr int LDS_BYTES = 147456;

struct Params { const float* in[24]; float* out; unsigned char* ws; int ph_lo, ph_hi; };

DI unsigned pk2(float lo, float hi) { f32x2_t v = {lo, hi}; bf16x2_t b = __builtin_convertvector(v, bf16x2_t); return __builtin_bit_cast(unsigned, b); }
DI float bf2f(unsigned short u) { return __builtin_bit_cast(float, (unsigned)u << 16); }
DI float bflo(unsigned u) { return __builtin_bit_cast(float, u << 16); }
DI float bfhi(unsigned u) { return __builtin_bit_cast(float, u & 0xffff0000u); }
DI float wave_sum(float v) {
#pragma unroll
    for (int o = 1; o < 64; o <<= 1) v += __shfl_xor(v, o);
    return v;
}
DI float half_sum(float v) {
#pragma unroll
    for (int o = 1; o < 32; o <<= 1) v += __shfl_xor(v, o);
    return v;
}
DI float fexp2(float x) { return __builtin_amdgcn_exp2f(x); }
DI float flog2(float x) { return __builtin_amdgcn_logf(x); }
DI float frcp(float x) { return __builtin_amdgcn_rcpf(x); }
DI float silu_f(float v) { return v * frcp(1.f + fexp2(-1.4426950408889634f * v)); }
DI float gelu_tanh_f(float v) { const float u = v * (1.f + 0.044715f * v * v); return v * frcp(1.f + fexp2(-2.302208198f * u)); }
#define MFMA32(a, b, c) __builtin_amdgcn_mfma_f32_32x32x16_bf16((a), (b), (c), 0, 0, 0)
DI int crow(int i, int hh) { return (i & 3) + 8 * (i >> 2) + 4 * hh; }
DI int pi32(int m) { return (m & 0x13) | ((m & 8) >> 1) | ((m & 4) << 1); }
DI bf16x8 ld8_bf(const bf16* p) { return *(const bf16x8*)p; }
DI bf16x8 ld8_f32(const float* p) { const f32x4 a = *(const f32x4*)p, b = *(const f32x4*)(p + 4); u32x4 r = {pk2(a.x, a.y), pk2(a.z, a.w), pk2(b.x, b.y), pk2(b.z, b.w)}; return __builtin_bit_cast(bf16x8, r); }
DI bf16x8 pack8(float a0, float a1, float a2, float a3, float a4, float a5, float a6, float a7) { u32x4 r = {pk2(a0, a1), pk2(a2, a3), pk2(a4, a5), pk2(a6, a7)}; return __builtin_bit_cast(bf16x8, r); }
DI f32x16 zero16() { f32x16 z;
#pragma unroll
    for (int i = 0; i < 16; ++i) z[i] = 0.f; return z; }

struct EpiF32 {
    static constexpr bool PERM = true, AFTER_DRAIN = false;
    float* O; int ldc;
    DI void operator()(const pg8::f32x4 (&acc)[2][2][4][2], const pg8::Unit& u, int wr, int wc, int fr, int fq) const {
        const int row0 = u.pm * 256 + wr * 64 + fr, col0 = u.pn * 256 + wc * 32 + 8 * fq;
#pragma unroll
        for (int ai = 0; ai < 2; ++ai)
#pragma unroll
            for (int m = 0; m < 4; ++m) { float* rp = O + (size_t)(row0 + ai * 128 + m * 16) * ldc + col0;
#pragma unroll
                for (int bj = 0; bj < 2; ++bj) { *(f32x4*)(rp + bj * 128) = acc[ai][bj][m][0]; *(f32x4*)(rp + bj * 128 + 4) = acc[ai][bj][m][1]; } }
    }
};
struct EpiInProj {
    static constexpr bool PERM = true, AFTER_DRAIN = false;
    unsigned char* ws; float* out;
    DI void operator()(const pg8::f32x4 (&acc)[2][2][4][2], const pg8::Unit& u, int wr, int wc, int fr, int fq) const {
        const int row0 = u.pm * 256 + wr * 64 + fr; const int pn = u.pn;
        bf16* dst; int ldd, colb; float* fo_p = nullptr; float* fo_s = nullptr;
        if (pn < 8) { const int t = pn >> 1; dst = (bf16*)(ws + WS_Q + (size_t)t * (WS_K - WS_Q)); ldd = 512; colb = (pn & 1) * 256 + wc * 32 + 8 * fq;
            if (t == 1) { fo_p = out + O_KP; fo_s = out + O_KS; } else if (t == 2) { fo_p = out + O_VP; fo_s = out + O_VS; } }
        else { dst = (bf16*)(ws + WS_XBC); ldd = CONVD; colb = (pn - 8) * 256 + wc * 32 + 8 * fq; }
#pragma unroll
        for (int ai = 0; ai < 2; ++ai)
#pragma unroll
            for (int m = 0; m < 4; ++m) { const int row = row0 + ai * 128 + m * 16;
#pragma unroll
                for (int bj = 0; bj < 2; ++bj) { const pg8::f32x4 v0 = acc[ai][bj][m][0], v1 = acc[ai][bj][m][1]; const int col = colb + bj * 128;
                    u32x4 w = {pk2(v0[0], v0[1]), pk2(v0[2], v0[3]), pk2(v1[0], v1[1]), pk2(v1[2], v1[3])};
                    *(u32x4*)(dst + (size_t)row * ldd + col) = w;
                    if (fo_p) { float* fp = (row < MP) ? fo_p + (size_t)row * 512 + col : fo_s + (size_t)(row - MP) * 512 + col; *(f32x4*)fp = v0; *(f32x4*)(fp + 4) = v1; }
                    if (pn >= 8) {
                        float* fp = nullptr;
                        if (row < MP) { const int t = row & (LP - 1); if (t >= LP - 3) fp = out + O_CSP + ((size_t)(row >> 11) * 3 + (t - (LP - 3))) * CONVD + col; }
                        else { const int rr = row - MP, t = rr & (LS - 1); if (t >= LS - 3) fp = out + O_CSS + ((size_t)(rr >> 5) * 3 + (t - (LS - 3))) * CONVD + col; }
                        if (fp) { *(f32x4*)fp = v0; *(f32x4*)(fp + 4) = v1; } } } }
    }
};
struct EpiUp {
    static constexpr bool PERM = true, AFTER_DRAIN = false;
    bf16* G; bf16* U; float* out;
    DI void operator()(const pg8::f32x4 (&acc)[2][2][4][2], const pg8::Unit& u, int wr, int wc, int fr, int fq) const {
        const int row0 = u.pm * 256 + wr * 64 + fr, col = u.pn * 128 + wc * 32 + 8 * fq;
#pragma unroll
        for (int ai = 0; ai < 2; ++ai)
#pragma unroll
            for (int m = 0; m < 4; ++m) { const int row = row0 + ai * 128 + m * 16;
#pragma unroll
                for (int bj = 0; bj < 2; ++bj) { const pg8::f32x4 v0 = acc[ai][bj][m][0], v1 = acc[ai][bj][m][1];
                    u32x4 w = {pk2(v0[0], v0[1]), pk2(v0[2], v0[3]), pk2(v1[0], v1[1]), pk2(v1[2], v1[3])};
                    *(u32x4*)((bj ? U : G) + (size_t)row * DFF + col) = w;
                    if (bj == 0) {
                        float* fp = nullptr;
                        if (row < MP) { const int t = row & (LP - 1); if (t >= LP - 2) fp = out + O_CFP + ((size_t)(row >> 11) * 2 + (t - (LP - 2))) * DFF + col; }
                        else { const int rr = row - MP, t = rr & (LS - 1); if (t >= LS - 2) fp = out + O_CFS + ((size_t)(rr >> 5) * 2 + (t - (LS - 2))) * DFF + col; }
                        if (fp) { *(f32x4*)fp = v0; *(f32x4*)(fp + 4) = v1; } } } }
    }
};

DI void p0_transpose_item(const float* W, int ldw, int K, bf16* WT, int dst_row0, int k0, int n0, LAS float* scr, int lane) {
#pragma unroll 8
    for (int i = 0; i < 32; ++i) { const int kk = 2 * i + (lane >> 5); scr[kk * 33 + (lane & 31)] = W[(size_t)(k0 + kk) * ldw + n0 + (lane & 31)]; }
    asm volatile("s_waitcnt lgkmcnt(0)" ::: "memory");
    const int c = lane & 7;
#pragma unroll
    for (int j = 0; j < 4; ++j) { const int n = (lane >> 3) + 8 * j; const LAS float* s = scr + (8 * c) * 33 + n;
        u32x4 o = {pk2(s[0 * 33], s[1 * 33]), pk2(s[2 * 33], s[3 * 33]), pk2(s[4 * 33], s[5 * 33]), pk2(s[6 * 33], s[7 * 33])};
        *(u32x4*)(WT + (size_t)(dst_row0 + n) * K + k0 + 8 * c) = o; }
    asm volatile("s_waitcnt lgkmcnt(0)" ::: "memory");
}
DI void phase_prologue(const Params& p, LAS unsigned char* lds) {
    const int tid = threadIdx.x, lane = tid & 63, wave = __builtin_amdgcn_readfirstlane(tid >> 6);
    const int gw = blockIdx.x * 8 + wave, NGW = gridDim.x * 8;
    LAS float* scr = (LAS float*)(lds + wave * 8448);
    LAS float* wdt = (LAS float*)(lds + 8 * 8448);
    const float* w_in = p.in[9];
    for (int k = tid; k < DM; k += 512) { const f32x4 a = *(const f32x4*)(w_in + (size_t)k * DIN + NPROJ), b = *(const f32x4*)(w_in + (size_t)k * DIN + NPROJ + 4);
        wdt[0 * DM + k] = a.x; wdt[1 * DM + k] = a.y; wdt[2 * DM + k] = a.z; wdt[3 * DM + k] = a.w; wdt[4 * DM + k] = b.x; wdt[5 * DM + k] = b.y; wdt[6 * DM + k] = b.z; wdt[7 * DM + k] = b.w; }
    constexpr int I_IN = 16 * 88, I_OUT = 16 * 32, I_UP = 16 * 176, I_DN = 44 * 32, NITEMS = I_IN + I_OUT + I_UP + I_DN;
    for (int it = gw; it < NITEMS; it += NGW) {
        int r = it;
        if (r < I_IN) { const int kb = r / 88, nb = r % 88; p0_transpose_item(w_in, DIN, DM, (bf16*)(p.ws + WS_WIN), 32 * nb, 64 * kb, 32 * nb, scr, lane); continue; } r -= I_IN;
        if (r < I_OUT) { const int kb = r / 32, nb = r % 32; p0_transpose_item(p.in[17], DM, DM, (bf16*)(p.ws + WS_WOUT), 32 * nb, 64 * kb, 32 * nb, scr, lane); continue; } r -= I_OUT;
        if (r < I_UP) { const int kb = r / 176, nb = r % 176, n0 = 32 * nb, isup = n0 >= DFF, j = n0 - isup * DFF;
            p0_transpose_item(p.in[20], NUP, DM, (bf16*)(p.ws + WS_WUP), (j >> 7) * 256 + isup * 128 + (j & 127), 64 * kb, n0, scr, lane); continue; } r -= I_UP;
        { const int kb = r / 32, nb = r % 32; p0_transpose_item(p.in[23], DM, DFF, (bf16*)(p.ws + WS_WDN), 32 * nb, 64 * kb, 32 * nb, scr, lane); }
    }
    __syncthreads();
    const float* g = p.in[7];
    f32x4 gv[4];
#pragma unroll
    for (int j = 0; j < 4; ++j) gv[j] = *(const f32x4*)(g + 4 * lane + 256 * j);
    for (int row = gw; row < MT; row += NGW) {
        const float* xr = (row < MP) ? p.in[0] + (size_t)row * DM : p.in[1] + (size_t)(row - MP) * DM;
        f32x4 v[4]; float s = 0.f;
#pragma unroll
        for (int j = 0; j < 4; ++j) { v[j] = *(const f32x4*)(xr + 4 * lane + 256 * j); s += (v[j].x * v[j].x + v[j].y * v[j].y) + (v[j].z * v[j].z + v[j].w * v[j].w); }
        const float rstd = __builtin_amdgcn_rsqf(wave_sum(s) * (1.f / DM) + EPS);
#pragma unroll
        for (int j = 0; j < 4; ++j) v[j] = v[j] * rstd * gv[j];
        bf16* orow = (bf16*)(p.ws + WS_A16) + (size_t)row * DM;
#pragma unroll
        for (int j = 0; j < 4; ++j) { u32x2 o = {pk2(v[j].x, v[j].y), pk2(v[j].z, v[j].w)}; *(u32x2*)(orow + 4 * lane + 256 * j) = o; }
        float d[8];
#pragma unroll
        for (int q = 0; q < 8; ++q) { float a = 0.f;
#pragma unroll
            for (int j = 0; j < 4; ++j) { const f32x4 w = *(const LAS f32x4*)(wdt + q * DM + 4 * lane + 256 * j); a += (v[j].x * w.x + v[j].y * w.y) + (v[j].z * w.z + v[j].w * w.w); }
            d[q] = wave_sum(a); }
        if (lane == 0) { float* dp = (float*)(p.ws + WS_DT) + (size_t)row * 8; *(f32x4*)dp = (f32x4){d[0], d[1], d[2], d[3]}; *(f32x4*)(dp + 4) = (f32x4){d[4], d[5], d[6], d[7]}; }
    }
}

constexpr float ATT_C2 = 0.125f * 1.4426950408889634f;
constexpr float ATT_EXIT = 92.f;
constexpr int VS_PITCH = 68;

template <bool F32>
DI void attn_step(const void* Kp, const void* Vp, int nrows, int kbase, int q_abs, const bf16x8 (&qf)[4], f32x16 (&o)[2], float& R, LAS bf16* vs, int lane) {
    const int r = lane & 31, hh = lane >> 5;
    int krow = pi32(r); krow = krow < nrows ? krow : nrows - 1;
    bf16x8 kf[4];
#pragma unroll
    for (int s = 0; s < 4; ++s) { const size_t off = (size_t)krow * 512 + 16 * s + 8 * hh; kf[s] = F32 ? ld8_f32((const float*)Kp + off) : ld8_bf((const bf16*)Kp + off); }
#pragma unroll
    for (int i = 0; i < 4; ++i) { const int key = (lane & 7) + 8 * i, dch = lane >> 3; const int kr = key < nrows ? key : nrows - 1; const size_t off = (size_t)kr * 512 + dch * 8;
        const bf16x8 v = F32 ? ld8_f32((const float*)Vp + off) : ld8_bf((const bf16*)Vp + off); const u32x4 vu = __builtin_bit_cast(u32x4, v);
        LAS u32x2* d = (LAS u32x2*)(vs + key * VS_PITCH + dch * 8); d[0] = (u32x2){vu.x, vu.y}; d[1] = (u32x2){vu.z, vu.w}; }
    f32x16 st = zero16();
#pragma unroll
    for (int s = 0; s < 4; ++s) st = MFMA32(kf[s], qf[s], st);
    float z[16], c[16]; bool valid[16];
#pragma unroll
    for (int i = 0; i < 16; ++i) { const int key = kbase + 16 * (i >> 3) + 8 * hh + (i & 7); valid[i] = key < q_abs; z[i] = st[i] * ATT_C2;
        const float sp = fmaxf(z[i], 0.f) + flog2(1.f + fexp2(-fabsf(z[i]))); c[i] = valid[i] ? sp : 0.f; }
#pragma unroll
    for (int i = 6; i >= 0; --i) { c[i] += c[i + 1]; c[8 + i] += c[8 + i + 1]; }
    const float g0 = c[0], g1 = c[8], og0 = __shfl_xor(g0, 32), og1 = __shfl_xor(g1, 32);
    const float b1 = R + (hh ? 0.f : og1), b0 = R + (hh ? (og1 + g1) : (og0 + g1 + og1));
    float w[16];
#pragma unroll
    for (int i = 0; i < 16; ++i) { const float e = fexp2(z[i] - (c[i] + (i < 8 ? b0 : b1))); w[i] = valid[i] ? e : 0.f; }
    R += (g0 + g1) + (og0 + og1);
    const bf16x8 pf0 = pack8(w[0], w[1], w[2], w[3], w[4], w[5], w[6], w[7]), pf1 = pack8(w[8], w[9], w[10], w[11], w[12], w[13], w[14], w[15]);
#pragma unroll
    for (int s = 0; s < 2; ++s)
#pragma unroll
        for (int db = 0; db < 2; ++db) { const LAS bf16* vp = vs + (16 * s + 8 * hh) * VS_PITCH + r + 32 * db;
            bf16x8 vf;
#pragma unroll
            for (int j = 0; j < 8; ++j) vf[j] = (short)vp[j * VS_PITCH];
            o[db] = MFMA32(s ? pf1 : pf0, vf, o[db]); }
}

template <bool SAMPLE>
DI void attn_item(const Params& p, int b, int qblk, LAS unsigned char* lds) {
    const int tid = threadIdx.x, lane = tid & 63, head = __builtin_amdgcn_readfirstlane(tid >> 6), r = lane & 31, hh = lane >> 5;
    LAS bf16* vs = (LAS bf16*)(lds + head * (32 * VS_PITCH * 2));
    LAS float* red = (LAS float*)(lds + 8 * (32 * VS_PITCH * 2));
    LAS float* rs = red + 256;
    const bf16* Qb = (const bf16*)(p.ws + WS_Q); const bf16* Kb = (const bf16*)(p.ws + WS_K); const bf16* Vb = (const bf16*)(p.ws + WS_V);
    const int tok0 = SAMPLE ? (MP + b * LS) : (b * LP + qblk * 32);
    bf16x8 qf[4];
#pragma unroll
    for (int s = 0; s < 4; ++s) qf[s] = ld8_bf(Qb + (size_t)(tok0 + r) * 512 + head * 64 + 16 * s + 8 * hh);
    f32x16 o[2]; o[0] = zero16(); o[1] = zero16();
    float R = 0.f;
    const int q_abs = SAMPLE ? (PAST + r) : (qblk * 32 + r);
    if (SAMPLE) {
        attn_step<false>(Kb + (size_t)tok0 * 512 + head * 64, Vb + (size_t)tok0 * 512 + head * 64, 32, PAST, q_abs, qf, o, R, vs, lane);
        const float* ck = p.in[2] + (size_t)b * PAST * 512 + head * 64; const float* cv = p.in[3] + (size_t)b * PAST * 512 + head * 64;
        for (int j = 1; j <= PAST / 32; ++j) {
            if (__ballot(R < ATT_EXIT) == 0ull) break;
            const int kbase = PAST - 32 * j;
            attn_step<true>(ck + (size_t)kbase * 512, cv + (size_t)kbase * 512, 32, kbase, q_abs, qf, o, R, vs, lane);
        }
    } else {
        for (int j = qblk; j >= 0; --j) {
            const size_t ro = (size_t)(b * LP + j * 32) * 512 + head * 64;
            attn_step<false>(Kb + ro, Vb + ro, 32, j * 32, q_abs, qf, o, R, vs, lane);
            if (__ballot(R < ATT_EXIT) == 0ull) break;
        }
    }
    float ss[16];
#pragma unroll
    for (int i = 0; i < 16; ++i) ss[i] = half_sum(o[0][i] * o[0][i] + o[1][i] * o[1][i]);
    if (r == 0) {
#pragma unroll
        for (int i = 0; i < 16; ++i) red[head * 32 + crow(i, hh)] = ss[i]; }
    __syncthreads();
    if (tid < 32) { float a = 0.f;
#pragma unroll
        for (int w = 0; w < 8; ++w) a += red[w * 32 + tid];
        rs[tid] = __builtin_amdgcn_rsqf(a * (1.f / 512.f) + EPS); }
    __syncthreads();
    const float* ga = p.in[16];
    const float g0 = ga[head * 64 + r], g1 = ga[head * 64 + 32 + r];
    bf16* mix = (bf16*)(p.ws + WS_A16);
#pragma unroll
    for (int i = 0; i < 16; ++i) { const int q = crow(i, hh); const float sc = rs[q]; bf16* mp = mix + (size_t)(tok0 + q) * DM + head * 64 + r;
        mp[0] = (bf16)(pk2(o[0][i] * sc * g0, 0.f) & 0xffffu); mp[32] = (bf16)(pk2(o[1][i] * sc * g1, 0.f) & 0xffffu); }
    __syncthreads();
}

constexpr int XT_PITCH = 72;
constexpr int SSD_XT = 0, SSD_B = 8 * 9216, SSD_C = SSD_B + 2 * 9216, SSD_W = SSD_C + 2 * 9216, SSD_RED = SSD_W + 8 * 768, SSD_RS = SSD_RED + 2048;

template <int MODE>
DI void conv64(const bf16* xcol  , float h0, float h1, float h2, float w0, float w1, float w2, float w3, float bias, int nvalid,
               LAS bf16* dst, int ch, const LAS float* wgt) {
    float x3 = h0, x2 = h1, x1 = h2;
#pragma unroll 2
    for (int t8 = 0; t8 < 8; ++t8) {
        float xv[8], y[8];
#pragma unroll
        for (int j = 0; j < 8; ++j) { const int t = t8 * 8 + j; xv[j] = (t < nvalid) ? bf2f(xcol[(size_t)t * CONVD]) : 0.f; }
#pragma unroll
        for (int j = 0; j < 8; ++j) { const float v = bias + w0 * x3 + w1 * x2 + w2 * x1 + w3 * xv[j]; y[j] = silu_f(v); x3 = x2; x2 = x1; x1 = xv[j]; }
        if (MODE == 0) {
#pragma unroll
            for (int j = 0; j < 8; ++j) y[j] *= wgt[t8 * 8 + j]; }
        if (MODE == 2) {
#pragma unroll
            for (int j = 0; j < 8; ++j) dst[(t8 * 8 + j) * XT_PITCH + ch] = (bf16)(pk2(y[j], 0.f) & 0xffffu);
        } else {
            *(LAS bf16x8*)(dst + ch * XT_PITCH + t8 * 8) = pack8(y[0], y[1], y[2], y[3], y[4], y[5], y[6], y[7]);
        }
    }
}

template <int PHASE, bool SAMPLE>
DI void ssd_item(const Params& p, int b, int c, LAS unsigned char* lds) {
    const int tid = threadIdx.x, lane = tid & 63, h = __builtin_amdgcn_readfirstlane(tid >> 6), r = lane & 31, hh = lane >> 5, g = h >> 2;
    const int tok0 = SAMPLE ? (MP + b * LS) : (b * LP + c * 64), nvalid = SAMPLE ? LS : 64;
    LAS bf16* XT = (LAS bf16*)(lds + SSD_XT + h * 9216);
    LAS bf16* Bs = (LAS bf16*)(lds + SSD_B + g * 9216);
    LAS bf16* Cs = (LAS bf16*)(lds + SSD_C + g * 9216);
    LAS float* dtw = (LAS float*)(lds + SSD_W + h * 768); LAS float* acw = dtw + 64; LAS float* exw = dtw + 128;
    LAS float* red = (LAS float*)(lds + SSD_RED); LAS float* rs = (LAS float*)(lds + SSD_RS);
    const float a_h = -expf(p.in[13][h]);
    float dt = 0.f;
    if (lane < nvalid) { const float x = ((const float*)(p.ws + WS_DT))[(size_t)(tok0 + lane) * 8 + h] + p.in[12][h]; dt = x > 20.f ? x : log1pf(expf(x)); }
    float ac = dt * a_h;
#pragma unroll
    for (int o = 1; o < 64; o <<= 1) { const float t = __shfl_up(ac, o); if (lane >= o) ac += t; }
    const float atot = __shfl(ac, 63);
    dtw[lane] = dt; acw[lane] = ac; exw[lane] = (PHASE == 1) ? expf(atot - ac) * dt : expf(ac);
    const bf16* XBC = (const bf16*)(p.ws + WS_XBC);
    const float* cw = p.in[10]; const float* cb = p.in[11];
    {
        const int ch = h * 64 + lane;
        float h0 = 0.f, h1 = 0.f, h2 = 0.f;
        if (SAMPLE) { const float* sp = p.in[5] + (size_t)b * 3 * CONVD + ch; h0 = sp[0]; h1 = sp[CONVD]; h2 = sp[2 * CONVD]; }
        else if (c > 0) { const bf16* hp = XBC + (size_t)(tok0 - 3) * CONVD + ch; h0 = bf2f(hp[0]); h1 = bf2f(hp[CONVD]); h2 = bf2f(hp[2 * CONVD]); }
        conv64<(PHASE == 1) ? 0 : 1>(XBC + (size_t)tok0 * CONVD + ch, h0, h1, h2, cw[ch], cw[CONVD + ch], cw[2 * CONVD + ch], cw[3 * CONVD + ch], cb[ch], nvalid, XT, lane, exw);
    }
    if ((h & 3) < 2 && (PHASE == 3 || (h & 3) == 0)) {
        const int isC = h & 3; const int ch = 512 + isC * 128 + g * 64 + lane;
        float h0 = 0.f, h1 = 0.f, h2 = 0.f;
        if (SAMPLE) { const float* sp = p.in[5] + (size_t)b * 3 * CONVD + ch; h0 = sp[0]; h1 = sp[CONVD]; h2 = sp[2 * CONVD]; }
        else if (c > 0) { const bf16* hp = XBC + (size_t)(tok0 - 3) * CONVD + ch; h0 = bf2f(hp[0]); h1 = bf2f(hp[CONVD]); h2 = bf2f(hp[2 * CONVD]); }
        conv64<(PHASE == 1) ? 1 : 2>(XBC + (size_t)tok0 * CONVD + ch, h0, h1, h2, cw[ch], cw[CONVD + ch], cw[2 * CONVD + ch], cw[3 * CONVD + ch], cb[ch], nvalid, isC ? Cs : Bs, lane, exw);
    }
    __syncthreads();
    if (PHASE == 1) {
        f32x16 st[2][2];
#pragma unroll
        for (int i = 0; i < 2; ++i)
#pragma unroll
            for (int j = 0; j < 2; ++j) st[i][j] = zero16();
#pragma unroll
        for (int ks = 0; ks < 4; ++ks) { bf16x8 a[2], bb[2];
#pragma unroll
            for (int i = 0; i < 2; ++i) { a[i] = *(const LAS bf16x8*)(XT + (r + 32 * i) * XT_PITCH + 16 * ks + 8 * hh); bb[i] = *(const LAS bf16x8*)(Bs + (r + 32 * i) * XT_PITCH + 16 * ks + 8 * hh); }
#pragma unroll
            for (int i = 0; i < 2; ++i)
#pragma unroll
                for (int j = 0; j < 2; ++j) st[i][j] = MFMA32(a[i], bb[j], st[i][j]); }
        if (SAMPLE) {
            const float dec = expf(atot); const float* h0p = p.in[4] + (size_t)(b * NH + h) * 4096; float* op = p.out + O_HS + (size_t)(b * NH + h) * 4096;
#pragma unroll
            for (int pb = 0; pb < 2; ++pb)
#pragma unroll
                for (int nb = 0; nb < 2; ++nb)
#pragma unroll
                    for (int i = 0; i < 16; ++i) { const int idx = (crow(i, hh) + 32 * pb) * 64 + r + 32 * nb; op[idx] = dec * h0p[idx] + st[pb][nb][i]; }
        } else {
            float* sp = (float*)(p.ws + WS_ST) + (size_t)((b * NCH + c) * NH + h) * 4096;
#pragma unroll
            for (int pb = 0; pb < 2; ++pb)
#pragma unroll
                for (int nb = 0; nb < 2; ++nb)
#pragma unroll
                    for (int i = 0; i < 16; ++i) sp[(crow(i, hh) + 32 * pb) * 64 + r + 32 * nb] = st[pb][nb][i];
            if (lane == 0) ((float*)(p.ws + WS_DEC))[(b * NCH + c) * NH + h] = expf(atot);
        }
    } else {
        const float* Hin = SAMPLE ? p.in[4] + (size_t)(b * NH + h) * 4096 : (const float*)(p.ws + WS_ST) + (size_t)((b * NCH + c) * NH + h) * 4096;
        f32x16 acc[2][2];
#pragma unroll
        for (int i = 0; i < 2; ++i)
#pragma unroll
            for (int j = 0; j < 2; ++j) acc[i][j] = zero16();
#pragma unroll
        for (int ks = 0; ks < 4; ++ks) { bf16x8 a[2], bb[2];
#pragma unroll
            for (int i = 0; i < 2; ++i) { a[i] = *(const LAS bf16x8*)(Cs + (r + 32 * i) * XT_PITCH + 16 * ks + 8 * hh); bb[i] = ld8_f32(Hin + (size_t)(r + 32 * i) * 64 + 16 * ks + 8 * hh); }
#pragma unroll
            for (int i = 0; i < 2; ++i)
#pragma unroll
                for (int j = 0; j < 2; ++j) acc[i][j] = MFMA32(a[i], bb[j], acc[i][j]); }
#pragma unroll
        for (int tb = 0; tb < 2; ++tb)
#pragma unroll
            for (int i = 0; i < 16; ++i) { const float e = exw[crow(i, hh) + 32 * tb]; acc[tb][0][i] *= e; acc[tb][1][i] *= e; }
        const float Dh = p.in[14][h];
#pragma unroll
        for (int tb = 0; tb < 2; ++tb) {
            const int t = r + 32 * tb; const float at = acw[t];
#pragma unroll
            for (int sb = 0; sb <= tb; ++sb) {
                __builtin_amdgcn_sched_barrier(0);
                f32x16 cbt = zero16();
#pragma unroll
                for (int ks = 0; ks < 4; ++ks) { const bf16x8 a = *(const LAS bf16x8*)(Bs + (pi32(r) + 32 * sb) * XT_PITCH + 16 * ks + 8 * hh); const bf16x8 bb = *(const LAS bf16x8*)(Cs + t * XT_PITCH + 16 * ks + 8 * hh);
                    cbt = MFMA32(a, bb, cbt); }
                float mv[16];
#pragma unroll
                for (int i = 0; i < 16; ++i) { const int s = 32 * sb + 16 * (i >> 3) + 8 * hh + (i & 7); const float e = expf(at - acw[s]) * dtw[s] * cbt[i]; mv[i] = (s <= t) ? e : 0.f; if (s == t) mv[i] += Dh; }
                const bf16x8 pf0 = pack8(mv[0], mv[1], mv[2], mv[3], mv[4], mv[5], mv[6], mv[7]), pf1 = pack8(mv[8], mv[9], mv[10], mv[11], mv[12], mv[13], mv[14], mv[15]);
#pragma unroll
                for (int ks2 = 0; ks2 < 2; ++ks2)
#pragma unroll
                    for (int pb = 0; pb < 2; ++pb) { const bf16x8 bb = *(const LAS bf16x8*)(XT + (r + 32 * pb) * XT_PITCH + 32 * sb + 16 * ks2 + 8 * hh); acc[tb][pb] = MFMA32(ks2 ? pf1 : pf0, bb, acc[tb][pb]); }
            }
        }
        const bf16* Zb = (const bf16*)(p.ws + WS_Z);
#pragma unroll
        for (int tb = 0; tb < 2; ++tb)
#pragma unroll
            for (int i4 = 0; i4 < 4; ++i4) {
                __builtin_amdgcn_sched_barrier(0);
#pragma unroll
                for (int ii = 0; ii < 4; ++ii) { const int i = i4 * 4 + ii; const int t = crow(i, hh) + 32 * tb; float s2 = 0.f;
                    if (t < nvalid) { const bf16* zp = Zb + (size_t)(tok0 + t) * 512 + h * 64 + r;
                        const float v0 = acc[tb][0][i] * silu_f(bf2f(zp[0])), v1 = acc[tb][1][i] * silu_f(bf2f(zp[32])); acc[tb][0][i] = v0; acc[tb][1][i] = v1; s2 = v0 * v0 + v1 * v1; }
                    s2 = half_sum(s2);
                    if (r == 0) red[h * 64 + t] = s2; }
            }
        __builtin_amdgcn_sched_barrier(0);
        __syncthreads();
        if (tid < 64) { float a = 0.f;
#pragma unroll
            for (int w = 0; w < 8; ++w) a += red[w * 64 + tid];
            rs[tid] = __builtin_amdgcn_rsqf(a * (1.f / 512.f) + EPS); }
        __syncthreads();
        const float* gs = p.in[15]; const float g0 = gs[h * 64 + r], g1 = gs[h * 64 + 32 + r];
        bf16* mix = (bf16*)(p.ws + WS_A16);
#pragma unroll
        for (int tb = 0; tb < 2; ++tb)
#pragma unroll
            for (int i = 0; i < 16; ++i) { const int t = crow(i, hh) + 32 * tb;
                if (t < nvalid) { const float sc = rs[t]; bf16* mp = mix + (size_t)(tok0 + t) * DM + 512 + h * 64 + r;
                    mp[0] = (bf16)(pk2(acc[tb][0][i] * sc * g0, 0.f) & 0xffffu); mp[32] = (bf16)(pk2(acc[tb][1][i] * sc * g1, 0.f) & 0xffffu); } }
    }
    __syncthreads();
}

DI void phase_scan(const Params& p) {
    const int gid = blockIdx.x * 512 + threadIdx.x;
    if (gid < NBP * NH * 1024) {
        const int bh = gid >> 10, e4 = gid & 1023, b = bh >> 3, h = bh & 7;
        float* st = (float*)(p.ws + WS_ST); const float* dec = (const float*)(p.ws + WS_DEC);
        f32x4 hs = {0.f, 0.f, 0.f, 0.f};
#pragma unroll 4
        for (int c = 0; c < NCH; ++c) { f32x4* sp = (f32x4*)(st + (size_t)((b * NCH + c) * NH + h) * 4096) + e4; const f32x4 t = *sp; *sp = hs; hs = hs * dec[(b * NCH + c) * NH + h] + t; }
        *((f32x4*)(p.out + O_HP + (size_t)bh * 4096) + e4) = hs;
    }
}
DI void phase_post_mixer(const Params& p) {
    const int lane = threadIdx.x & 63, gw = blockIdx.x * 8 + (threadIdx.x >> 6), NGW = gridDim.x * 8;
    f32x4 g1[4], g2[4];
#pragma unroll
    for (int j = 0; j < 4; ++j) { g1[j] = *(const f32x4*)(p.in[8] + 4 * lane + 256 * j); g2[j] = *(const f32x4*)(p.in[18] + 4 * lane + 256 * j); }
    for (int row = gw; row < MT; row += NGW) {
        const float* xr = (row < MP) ? p.in[0] + (size_t)row * DM : p.in[1] + (size_t)(row - MP) * DM;
        const float* mr = (const float*)(p.ws + WS_M) + (size_t)row * DM;
        f32x4 m[4], x[4]; float s = 0.f;
#pragma unroll
        for (int j = 0; j < 4; ++j) { m[j] = *(const f32x4*)(mr + 4 * lane + 256 * j); x[j] = *(const f32x4*)(xr + 4 * lane + 256 * j); s += (m[j].x * m[j].x + m[j].y * m[j].y) + (m[j].z * m[j].z + m[j].w * m[j].w); }
        const float r1 = __builtin_amdgcn_rsqf(wave_sum(s) * (1.f / DM) + EPS); float s2 = 0.f;
        float* hr = p.out + (size_t)row * DM;
#pragma unroll
        for (int j = 0; j < 4; ++j) { x[j] = x[j] + m[j] * r1 * g1[j]; *(f32x4*)(hr + 4 * lane + 256 * j) = x[j]; s2 += (x[j].x * x[j].x + x[j].y * x[j].y) + (x[j].z * x[j].z + x[j].w * x[j].w); }
        const float r2 = __builtin_amdgcn_rsqf(wave_sum(s2) * (1.f / DM) + EPS);
        bf16* orow = (bf16*)(p.ws + WS_A16) + (size_t)row * DM;
#pragma unroll
        for (int j = 0; j < 4; ++j) { const f32x4 v = x[j] * r2 * g2[j]; u32x2 o = {pk2(v.x, v.y), pk2(v.z, v.w)}; *(u32x2*)(orow + 4 * lane + 256 * j) = o; }
    }
}
DI void phase_final(const Params& p) {
    const int lane = threadIdx.x & 63, gw = blockIdx.x * 8 + (threadIdx.x >> 6), NGW = gridDim.x * 8;
    f32x4 g1[4];
#pragma unroll
    for (int j = 0; j < 4; ++j) g1[j] = *(const f32x4*)(p.in[19] + 4 * lane + 256 * j);
    for (int row = gw; row < MT; row += NGW) {
        const float* fr = (const float*)(p.ws + WS_F) + (size_t)row * DM; float* hr = p.out + (size_t)row * DM;
        f32x4 f[4], x[4]; float s = 0.f;
#pragma unroll
        for (int j = 0; j < 4; ++j) { f[j] = *(const f32x4*)(fr + 4 * lane + 256 * j); x[j] = *(const f32x4*)(hr + 4 * lane + 256 * j); s += (f[j].x * f[j].x + f[j].y * f[j].y) + (f[j].z * f[j].z + f[j].w * f[j].w); }
        const float r1 = __builtin_amdgcn_rsqf(wave_sum(s) * (1.f / DM) + EPS);
#pragma unroll
        for (int j = 0; j < 4; ++j) *(f32x4*)(hr + 4 * lane + 256 * j) = x[j] + f[j] * r1 * g1[j];
    }
}
DI void unpack8(const u32x4 v, float (&f)[8]) { f[0] = bflo(v.x); f[1] = bfhi(v.x); f[2] = bflo(v.y); f[3] = bfhi(v.y); f[4] = bflo(v.z); f[5] = bfhi(v.z); f[6] = bflo(v.w); f[7] = bfhi(v.w); }
DI void phase_act(const Params& p) {
    const bf16* G = (const bf16*)(p.ws + WS_G); bf16* U = (bf16*)(p.ws + WS_U);
    const float* cw = p.in[21]; const float* cb = p.in[22];
    const int total = gridDim.x * 512;
    for (int task = blockIdx.x * 512 + threadIdx.x; task < (MT / 32) * (DFF / 8); task += total) {
        const int run = task / (DFF / 8), col = (task % (DFF / 8)) * 8, row0 = run * 32;
        float w0[8], w1[8], w2[8], bs[8], g2[8], g1[8];
#pragma unroll
        for (int j = 0; j < 8; ++j) { w0[j] = cw[col + j]; w1[j] = cw[DFF + col + j]; w2[j] = cw[2 * DFF + col + j]; bs[j] = cb[col + j]; g2[j] = 0.f; g1[j] = 0.f; }
        if (row0 >= MP) { const float* sp = p.in[6] + (size_t)((row0 - MP) >> 5) * 2 * DFF + col;
#pragma unroll
            for (int j = 0; j < 8; ++j) { g2[j] = sp[j]; g1[j] = sp[DFF + j]; } }
        else if (row0 & (LP - 1)) { unpack8(*(const u32x4*)(G + (size_t)(row0 - 2) * DFF + col), g2); unpack8(*(const u32x4*)(G + (size_t)(row0 - 1) * DFF + col), g1); }
#pragma unroll 4
        for (int t = 0; t < 32; ++t) {
            float g0[8], uu[8], a[8];
            unpack8(*(const u32x4*)(G + (size_t)(row0 + t) * DFF + col), g0); unpack8(*(const u32x4*)(U + (size_t)(row0 + t) * DFF + col), uu);
#pragma unroll
            for (int j = 0; j < 8; ++j) { a[j] = gelu_tanh_f(bs[j] + w0[j] * g2[j] + w1[j] * g1[j] + w2[j] * g0[j]) * uu[j]; g2[j] = g1[j]; g1[j] = g0[j]; }
            u32x4 o = {pk2(a[0], a[1]), pk2(a[2], a[3]), pk2(a[4], a[5]), pk2(a[6], a[7])};
            *(u32x4*)(U + (size_t)(row0 + t) * DFF + col) = o;
        }
    }
}

constexpr int N_PHASES = 11;
__global__ void __launch_bounds__(512, 2) fwd_kernel(Params p) {
    extern __shared__ __attribute__((aligned(16))) unsigned char lds_raw[];
    LAS unsigned char* lds = (LAS unsigned char*)lds_raw;
    cg::grid_group grid = cg::this_grid();
    const int lo = p.ph_lo, hi = p.ph_hi;
#ifndef PH_MASK
#define PH_MASK 0x7ff
#endif
#define IN(k) (((PH_MASK >> (k)) & 1) && lo <= (k) && (k) < hi)
#define SEAM(k) do { if (IN(k) && IN((k) + 1)) grid.sync(); } while (0)
    const int G = gridDim.x, bx = blockIdx.x;
    if (IN(0)) phase_prologue(p, lds);
    SEAM(0);
    if (IN(1)) {
        pg8::Gemm g{(const pg8::bf16_t*)(p.ws + WS_A16), (const pg8::bf16_t*)(p.ws + WS_WIN), MT, NPROJ, DM}; pg8::StaticOrder S; S.init(MT, NPROJ, G, bx);
        EpiInProj E{p.ws, p.out};
        pg8::gemm_phase<EpiInProj, pg8::StaticOrder, true, true>(lds, g, S, E);
    }
    SEAM(1);
    if (IN(2)) {
        constexpr int NA_S = NBS, NA_P = NBP * (LP / 32), NS_P = NBP * NCH, NS_S = NBS, NIT = NA_S + NA_P + NS_P + NS_S;
        for (int it = bx; it < NIT; it += G) {
            int r = it;
            if (r < NA_S) { attn_item<true>(p, r, 0, lds); continue; } r -= NA_S;
            if (r < NA_P) { const int b = r & 7, qblk = 63 - (r >> 3); attn_item<false>(p, b, qblk, lds); continue; } r -= NA_P;
            if (r < NS_P) { ssd_item<1, false>(p, r / NCH, r % NCH, lds); continue; } r -= NS_P;
            ssd_item<1, true>(p, r, 0, lds);
        }
    }
    SEAM(2);
    if (IN(3)) phase_scan(p);
    SEAM(3);
    if (IN(4)) {
        constexpr int NS_P = NBP * NCH, NIT = NS_P + NBS;
        for (int it = bx; it < NIT; it += G) { if (it < NS_P) ssd_item<3, false>(p, it / NCH, it % NCH, lds); else ssd_item<3, true>(p, it - NS_P, 0, lds); }
    }
    SEAM(4);
    if (IN(5)) {
        pg8::Gemm g{(const pg8::bf16_t*)(p.ws + WS_A16), (const pg8::bf16_t*)(p.ws + WS_WOUT), MT, DM, DM}; pg8::StaticOrder S; S.init(MT, DM, G, bx);
        EpiF32 E{(float*)(p.ws + WS_M), DM};
        pg8::gemm_phase<EpiF32, pg8::StaticOrder, true, true>(lds, g, S, E);
    }
    SEAM(5);
    if (IN(6)) phase_post_mixer(p);
    SEAM(6);
    if (IN(7)) {
        pg8::Gemm g{(const pg8::bf16_t*)(p.ws + WS_A16), (const pg8::bf16_t*)(p.ws + WS_WUP), MT, NUP, DM}; pg8::StaticOrder S; S.init(MT, NUP, G, bx);
        EpiUp E{(bf16*)(p.ws + WS_G), (bf16*)(p.ws + WS_U), p.out};
        pg8::gemm_phase<EpiUp, pg8::StaticOrder, true, true>(lds, g, S, E);
    }
    SEAM(7);
    if (IN(8)) phase_act(p);
    SEAM(8);
    if (IN(9)) {
        pg8::Gemm g{(const pg8::bf16_t*)(p.ws + WS_U), (const pg8::bf16_t*)(p.ws + WS_WDN), MT, DM, DFF}; pg8::StaticOrder S; S.init(MT, DM, G, bx);
        EpiF32 E{(float*)(p.ws + WS_F), DM};
        pg8::gemm_phase<EpiF32, pg8::StaticOrder, true, true>(lds, g, S, E);
    }
    SEAM(9);
    if (IN(10)) phase_final(p);
#undef IN
#undef SEAM
}

#ifndef N_LAUNCHES
#define N_LAUNCHES 1
#endif
extern "C" void kernel_launch(void* const* d_in, const int* in_sizes, int n_in, void* d_out, int out_size, void* d_ws, size_t ws_size, hipStream_t stream) {
    static int grid = 0;
    if (grid == 0) {
        if (n_in != 24 || out_size != (int)O_END || ws_size < WS_NEED) { fprintf(stderr, "kernel_launch: unexpected shapes: n_in %d out %d ws %zu\n", n_in, out_size, ws_size); grid = -1; return; }
        int dev = 0, cus = 0, per_cu = 0;
        hipGetDevice(&dev); hipDeviceGetAttribute(&cus, hipDeviceAttributeMultiprocessorCount, dev);
        if (hipFuncSetAttribute((const void*)fwd_kernel, hipFuncAttributeMaxDynamicSharedMemorySize, LDS_BYTES) != hipSuccess) { fprintf(stderr, "kernel_launch: hipFuncSetAttribute failed\n"); grid = -1; return; }
        if (hipOccupancyMaxActiveBlocksPerMultiprocessor(&per_cu, (const void*)fwd_kernel, 512, LDS_BYTES) != hipSuccess || per_cu < 1) { fprintf(stderr, "kernel_launch: occupancy query says %d\n", per_cu); per_cu = 1; }
        (void)hipGetLastError();
        grid = cus * (per_cu > 1 ? 1 : per_cu);
        if (grid <= 0) grid = 256;
    }
    if (grid < 0) return;
    Params p{};
    for (int i = 0; i < 24; ++i) p.in[i] = (const float*)d_in[i];
    p.out = (float*)d_out; p.ws = (unsigned char*)d_ws;
#if N_LAUNCHES == 1
    p.ph_lo = 0; p.ph_hi = N_PHASES;
    void* args[] = {&p};
    hipError_t e = hipLaunchCooperativeKernel((const void*)fwd_kernel, dim3(grid), dim3(512), args, LDS_BYTES, stream);
    if (e != hipSuccess) fprintf(stderr, "cooperative launch failed: %s (grid %d)\n", hipGetErrorString(e), grid);
#else
    for (int k = 0; k < N_PHASES; ++k) { p.ph_lo = k; p.ph_hi = k + 1; hipLaunchKernelGGL(fwd_kernel, dim3(grid), dim3(512), LDS_BYTES, stream, p); }
#endif
}
```

```cpp
#include <hip/hip_runtime.h>
#include <hip/hip_cooperative_groups.h>
#include <cstdio>
#include <cstdint>
namespace cg = cooperative_groups;
namespace pg8 {
#define PG8_LAS __attribute__((address_space(3)))
typedef unsigned short bf16_t;
typedef short bf16x8 __attribute__((ext_vector_type(8)));
typedef float f32x4 __attribute__((ext_vector_type(4)));
typedef unsigned u32x4 __attribute__((ext_vector_type(4)));
constexpr int BM = 256, BK = 64, HALF = 128, HTB = HALF * BK * 2  , STAGE_BYTES = 8 * HTB, NXCD = 8, WGM = 8;

__host__ __device__ __forceinline__ int lds_byte(int r, int c) { const int st = (r >> 4) * 2 + (c >> 5), rr = r & 15, cc = c & 31, ob = rr * 64 + cc * 2; return st * 1024 + (ob ^ (((ob >> 9) & 1) << 5)); }
__host__ __device__ __forceinline__ void stage_rc(int b, int& R, int& C) { const int st = b / 1024, sb = b % 1024, swz = sb ^ (((sb >> 9) & 1) << 5); R = (st >> 1) * 16 + swz / 64; C = (st & 1) * 32 + (swz % 64) / 2; }
__host__ __device__ __forceinline__ int perm32(int rho) { const int n = rho >> 4, i = rho & 15; return 8 * (i >> 2) + 4 * n + (i & 3); }

struct Unit { int pm, pn; };
struct Gemm { const bf16_t* A; const bf16_t* Bt; int M, N, K, ldk; };

struct StaticOrder {
    int nM, nN, nwg, G, c;
    __host__ __device__ void init(int M, int N, int G_, int c_) { nM = M / BM; nN = N / BM; nwg = nM * nN; G = G_; c = c_; }
    __host__ __device__ bool next(int i, Unit& u) const {
        const long L = (long)i * G + c; if (L >= nwg) return false;
        int wgid = (int)L; { const int q = nwg / NXCD, r = nwg % NXCD, xcd = wgid % NXCD, off = wgid / NXCD; wgid = (xcd < r ? xcd * (q + 1) : r * (q + 1) + (xcd - r) * q) + off; }
        const int nig = WGM * nN, gid = wgid / nig, fm = gid * WGM, gsz = (nM - fm) < WGM ? (nM - fm) : WGM;
        u.pm = fm + ((wgid % nig) % gsz); u.pn = (wgid % nig) / gsz; return true;
    }
    __device__ __forceinline__ void a_ready(const Unit&) const {}
    __device__ __forceinline__ void done(const Unit&) const {}
    __device__ __forceinline__ size_t a_off(const Unit& u, size_t tstep) const { return (size_t)u.pm * tstep; }
    __device__ __forceinline__ size_t b_off(const Unit& u, size_t tstep) const { return (size_t)u.pn * tstep; }
};
struct SplitOrder {
    int pm0, nM, nN, nS, kpart, G, c;
    __device__ __forceinline__ bool next(int i, Unit& u) const { const int tot = nM * nN * nS; int L = i * G + c; if (L >= tot) return false;
        if ((G & 7) == 0 && (i + 1) * G <= tot) L = i * G + (c & 7) * (G >> 3) + (c >> 3);
        const int ks = L / (nM * nN), rem = L % (nM * nN); u.pm = rem / nN; u.pn = ks * nN + rem % nN; return true; }
    __device__ __forceinline__ void a_ready(const Unit&) const {}
    __device__ __forceinline__ void done(const Unit&) const {}
    __device__ __forceinline__ size_t a_off(const Unit& u, size_t tstep) const { return (size_t)(pm0 + u.pm) * tstep + (size_t)(u.pn / nN) * kpart * 2; }
    __device__ __forceinline__ size_t b_off(const Unit& u, size_t tstep) const { return (size_t)(u.pn % nN) * tstep + (size_t)(u.pn / nN) * kpart * 2; }
};
__device__ __forceinline__ unsigned cvt_pk_bf16(float lo, float hi) { unsigned r; asm volatile("v_cvt_pk_bf16_f32 %0, %1, %2" : "=v"(r) : "v"(lo), "v"(hi)); return r; }
template <class Epi, class Sched, bool ALIGN_EPI = false, bool SP2 = false>
__device__ __forceinline__ void gemm_phase(PG8_LAS unsigned char* lds, const Gemm g, const Sched& S, const Epi& E) {
    const int tid = threadIdx.x, wid = __builtin_amdgcn_readfirstlane(tid >> 6), lane = tid & 63, wr = wid >> 2, wc = wid & 3, fr = lane & 15, fq = lane >> 4;
    const int K = g.K, nt = K / BK;
    unsigned voffA[2], voffB[2];
#pragma unroll
    for (int i = 0; i < 2; ++i) { int R, C; stage_rc(tid * 16 + i * 8192, R, C); const int Rb = Epi::PERM ? ((R & ~31) + perm32(R & 31)) : R;
        voffA[i] = (unsigned)(R * g.ldk + C) * 2u; voffB[i] = (unsigned)(Rb * g.ldk + C) * 2u; }
    const size_t kstep = (size_t)(BK * 2);
    const size_t hstep = (size_t)HALF * g.ldk * 2;
    const size_t tstep = 2 * hstep;
    const unsigned ldsw = (unsigned)wid * 1024u;
    const int aoff = lds_byte(wr * 64 + fr, fq * 8), boff = lds_byte(wc * 32 + fr, fq * 8);
#define PG8_SA(b, h) (((b) * 2 + (h)) * HTB)
#define PG8_SB(b, h) ((4 + (b) * 2 + (h)) * HTB)
#define PG8_STAGE(bufoff, gbase, voff) do { _Pragma("unroll") for (int _i = 0; _i < 2; ++_i) \
        __builtin_amdgcn_global_load_lds((const unsigned*)((const char*)(gbase) + (voff)[_i]), (PG8_LAS unsigned*)(lds + (bufoff) + ldsw + _i * 8192), 16, 0, 0); } while (0)
#define PG8_LDA(dst, b, h) do { _Pragma("unroll") for (int m = 0; m < 4; ++m) _Pragma("unroll") for (int k = 0; k < 2; ++k) dst[m][k] = *(const PG8_LAS bf16x8*)(lds + PG8_SA(b, h) + aoff + m * 2048 + k * 1024); } while (0)
#define PG8_LDB(dst, b, h) do { _Pragma("unroll") for (int n = 0; n < 2; ++n) _Pragma("unroll") for (int k = 0; k < 2; ++k) dst[n][k] = *(const PG8_LAS bf16x8*)(lds + PG8_SB(b, h) + boff + n * 2048 + k * 1024); } while (0)
#define PG8_MMA(ai, bj, At, Bt) do { __builtin_amdgcn_s_setprio(1); _Pragma("unroll") for (int m = 0; m < 4; ++m) _Pragma("unroll") for (int n = 0; n < 2; ++n) _Pragma("unroll") for (int k = 0; k < 2; ++k) \
        acc[ai][bj][m][n] = __builtin_amdgcn_mfma_f32_16x16x32_bf16(Bt[n][k], At[m][k], acc[ai][bj][m][n], 0, 0, 0); __builtin_amdgcn_s_setprio(0); } while (0)
#define PG8_WAIT_V(n) asm volatile("s_waitcnt vmcnt(" #n ")" ::: "memory")
#define PG8_WAIT_L(n) asm volatile("s_waitcnt lgkmcnt(" #n ")" ::: "memory")
#define PG8_BAR __builtin_amdgcn_s_barrier()
#define PG8_SCHED __builtin_amdgcn_sched_barrier(0)
    Unit cur, nxt; int ui = 0;
    if (!S.next(0, cur)) return;
    f32x4 acc[2][2][4][2];
#pragma unroll
    for (int a = 0; a < 2; ++a)
#pragma unroll
        for (int b = 0; b < 2; ++b)
#pragma unroll
            for (int m = 0; m < 4; ++m)
#pragma unroll
                for (int n = 0; n < 2; ++n) acc[a][b][m][n] = (f32x4){0.f, 0.f, 0.f, 0.f};
    bf16x8 At[4][2], B0[2][2], B1[2][2];
    const char* cA = (const char*)g.A + S.a_off(cur, tstep); const char* cB = (const char*)g.Bt + S.b_off(cur, tstep);
    S.a_ready(cur);
    if constexpr (SP2) {
        PG8_STAGE(PG8_SB(0, 0), cB, voffB); PG8_STAGE(PG8_SB(0, 1), cB + hstep, voffB); PG8_STAGE(PG8_SA(0, 0), cA, voffA); PG8_STAGE(PG8_SA(0, 1), cA + hstep, voffA);
        if (wr == 1) PG8_BAR;
        PG8_WAIT_V(2); PG8_BAR;
        PG8_STAGE(PG8_SB(1, 0), cB + kstep, voffB); PG8_STAGE(PG8_SA(1, 0), cA + kstep, voffA); PG8_STAGE(PG8_SB(1, 1), cB + hstep + kstep, voffB);
        PG8_WAIT_V(6); PG8_BAR;
    } else {
        PG8_STAGE(PG8_SB(0, 0), cB, voffB); PG8_STAGE(PG8_SA(0, 0), cA, voffA); PG8_STAGE(PG8_SB(0, 1), cB + hstep, voffB); PG8_STAGE(PG8_SA(0, 1), cA + hstep, voffA);
        if (wr == 1) PG8_BAR;
        PG8_WAIT_V(4); PG8_BAR;
        PG8_STAGE(PG8_SB(1, 0), cB + kstep, voffB); PG8_STAGE(PG8_SA(1, 0), cA + kstep, voffA); PG8_STAGE(PG8_SB(1, 1), cB + hstep + kstep, voffB);
        PG8_WAIT_V(6); PG8_BAR;
    }
    for (;;) {
        const bool has_next = S.next(ui + 1, nxt);
        const char* nA = has_next ? (const char*)g.A + S.a_off(nxt, tstep) : cA; const char* nB = has_next ? (const char*)g.Bt + S.b_off(nxt, tstep) : cB;
        for (int t = 0; t < nt; t += 2) {
            const bool last = (t == nt - 2);
            const char* a1 = cA + (size_t)(t + 1) * kstep;
            const char* a2 = last ? nA : cA + (size_t)(t + 2) * kstep; const char* b2 = last ? nB : cB + (size_t)(t + 2) * kstep;
            const char* a3 = a2 + kstep; const char* b3 = b2 + kstep;
            if (last && has_next) S.a_ready(nxt);
            if constexpr (SP2) {
            PG8_LDB(B0, 0, 0); PG8_LDB(B1, 0, 1); PG8_SCHED; PG8_LDA(At, 0, 0); PG8_STAGE(PG8_SA(1, 1), a1 + hstep, voffA);
            PG8_WAIT_V(8); PG8_WAIT_L(0); PG8_BAR; PG8_MMA(0, 0, At, B0); PG8_MMA(0, 1, At, B1); PG8_BAR; PG8_SCHED;
            PG8_LDA(At, 0, 1); PG8_STAGE(PG8_SB(0, 0), b2, voffB); PG8_STAGE(PG8_SB(0, 1), b2 + hstep, voffB); PG8_STAGE(PG8_SA(0, 0), a2, voffA);
            PG8_WAIT_V(8); PG8_WAIT_L(0); PG8_BAR; PG8_MMA(1, 0, At, B0); PG8_MMA(1, 1, At, B1); PG8_BAR; PG8_SCHED;
            PG8_LDB(B0, 1, 0); PG8_LDB(B1, 1, 1); PG8_SCHED; PG8_LDA(At, 1, 0); PG8_STAGE(PG8_SA(0, 1), a2 + hstep, voffA);
            PG8_WAIT_V(8); PG8_WAIT_L(0); PG8_BAR; PG8_MMA(0, 0, At, B0); PG8_MMA(0, 1, At, B1); PG8_BAR; PG8_SCHED;
            PG8_LDA(At, 1, 1); PG8_STAGE(PG8_SB(1, 0), b3, voffB); PG8_STAGE(PG8_SB(1, 1), b3 + hstep, voffB); PG8_STAGE(PG8_SA(1, 0), a3, voffA);
            PG8_WAIT_V(8); PG8_WAIT_L(0); PG8_BAR; PG8_MMA(1, 0, At, B0); PG8_MMA(1, 1, At, B1); PG8_BAR; PG8_SCHED;
            } else {
            PG8_LDB(B0, 0, 0); PG8_SCHED; PG8_LDA(At, 0, 0); PG8_STAGE(PG8_SA(1, 1), a1 + hstep, voffA);
            PG8_WAIT_L(8); PG8_BAR; PG8_WAIT_L(0); PG8_MMA(0, 0, At, B0); PG8_BAR; PG8_SCHED;
            PG8_LDB(B1, 0, 1); PG8_STAGE(PG8_SB(0, 0), b2, voffB);
            PG8_BAR; PG8_WAIT_L(0); PG8_MMA(0, 1, At, B1); PG8_BAR;
            PG8_LDA(At, 0, 1); PG8_STAGE(PG8_SA(0, 0), a2, voffA);
            PG8_BAR; PG8_WAIT_L(0); PG8_MMA(1, 0, At, B0); PG8_BAR; PG8_SCHED;
            PG8_STAGE(PG8_SB(0, 1), b2 + hstep, voffB);
            PG8_WAIT_V(6); PG8_BAR; PG8_MMA(1, 1, At, B1); PG8_BAR;
            PG8_LDB(B0, 1, 0); PG8_SCHED; PG8_LDA(At, 1, 0); PG8_STAGE(PG8_SA(0, 1), a2 + hstep, voffA);
            PG8_WAIT_L(8); PG8_BAR; PG8_WAIT_L(0); PG8_MMA(0, 0, At, B0); PG8_BAR; PG8_SCHED;
            PG8_LDB(B1, 1, 1); PG8_STAGE(PG8_SB(1, 0), b3, voffB);
            PG8_BAR; PG8_WAIT_L(0); PG8_MMA(0, 1, At, B1); PG8_BAR;
            PG8_LDA(At, 1, 1); PG8_STAGE(PG8_SA(1, 0), a3, voffA);
            PG8_BAR; PG8_WAIT_L(0); PG8_MMA(1, 0, At, B0); PG8_BAR; PG8_SCHED;
            PG8_STAGE(PG8_SB(1, 1), b3 + hstep, voffB);
            PG8_WAIT_V(6); PG8_BAR; PG8_MMA(1, 1, At, B1); PG8_BAR;
            }
        }
        if constexpr (ALIGN_EPI) { if (wr == 0) PG8_BAR; }
        if constexpr (!Epi::AFTER_DRAIN) { E(acc, cur, wr, wc, fr, fq); S.done(cur); }
        if (!has_next) break;
#pragma unroll
        for (int a = 0; a < 2; ++a)
#pragma unroll
            for (int b = 0; b < 2; ++b)
#pragma unroll
                for (int m = 0; m < 4; ++m)
#pragma unroll
                    for (int n = 0; n < 2; ++n) acc[a][b][m][n] = (f32x4){0.f, 0.f, 0.f, 0.f};
        cur = nxt; cA = nA; cB = nB; ++ui;
        if constexpr (ALIGN_EPI) { if (wr == 1) PG8_BAR; }
    }
    PG8_WAIT_V(0);
    if constexpr (!ALIGN_EPI) { if (wr == 0) PG8_BAR; }
    PG8_BAR;
    if constexpr (Epi::AFTER_DRAIN) { E.fused(acc, cur, wr, wc, fr, fq, lds, wid, lane); S.done(cur); }
#undef PG8_SA
#undef PG8_SB
#undef PG8_STAGE
#undef PG8_LDA
#undef PG8_LDB
#undef PG8_MMA
#undef PG8_WAIT_V
#undef PG8_WAIT_L
#undef PG8_BAR
#undef PG8_SCHED
}
}

#define DI __device__ __forceinline__
#define LAS __attribute__((address_space(3)))
typedef unsigned short bf16;
typedef short bf16x8 __attribute__((ext_vector_type(8)));
typedef float f32x4 __attribute__((ext_vector_type(4)));
typedef float f32x16 __attribute__((ext_vector_type(16)));
typedef unsigned u32x4 __attribute__((ext_vector_type(4)));
typedef unsigned u32x2 __attribute__((ext_vector_type(2)));
typedef __bf16 bf16x2_t __attribute__((ext_vector_type(2)));
typedef float f32x2_t __attribute__((ext_vector_type(2)));

constexpr int DM = 1024, NBP = 8, LP = 2048, NBS = 16, LS = 32, PAST = 2048;
constexpr int MP = NBP * LP, MS = NBS * LS, MT = MP + MS;
constexpr int NPROJ = 2816, DIN = 2824, DFF = 2816, NUP = 5632;
constexpr int CONVD = 768, NH = 8;
constexpr float EPS = 1e-6f;
constexpr int NCH = LP / 64;

constexpr size_t O_YP = 0, O_YS = 16777216, O_KP = 17301504, O_VP = 25690112, O_HP = 34078720, O_CSP = 34340864, O_CFP = 34359296,
                 O_KS = 34404352, O_VS = 34666496, O_HS = 34928640, O_CSS = 35452928, O_CFS = 35489792, O_END = 35579904;

constexpr size_t MiB = 1u << 20;
constexpr size_t WS_WIN = 1 * MiB, WS_WOUT = 7 * MiB, WS_WUP = 9 * MiB, WS_WDN = 20 * MiB;
constexpr size_t WS_A16 = 26 * MiB;
constexpr size_t WS_G = 60 * MiB, WS_U = 151 * MiB;
constexpr size_t WS_Q = 60 * MiB, WS_K = 77 * MiB, WS_V = 94 * MiB, WS_Z = 111 * MiB;
constexpr size_t WS_XBC = 128 * MiB;
constexpr size_t WS_ST = 153 * MiB;
constexpr size_t WS_DEC = 185 * MiB;
constexpr size_t WS_DT = 186 * MiB;
constexpr size_t WS_M = 188 * MiB;
constexpr size_t WS_F = 60 * MiB;
constexpr size_t WS_TR = 188 * MiB, WS_NAT = 210 * MiB;
constexpr size_t WS_MS = 153 * MiB;
constexpr size_t WS_FS = 126 * MiB;
constexpr int KS_OUT = 4, KS_DN = 11;
constexpr size_t WS_NEED = 254 * MiB;

constexpr int LDS_BYTES = 147456;

struct Params { const float* in[24]; float* out; unsigned char* ws; int ph_lo, ph_hi; };
#define PARAMS_T const __attribute__((address_space(4))) Params&
#define NOINL __device__ __forceinline__

DI unsigned pk2(float lo, float hi) { f32x2_t v = {lo, hi}; bf16x2_t b = __builtin_convertvector(v, bf16x2_t); return __builtin_bit_cast(unsigned, b); }
DI float bf2f(unsigned short u) { return __builtin_bit_cast(float, (unsigned)u << 16); }
DI float bflo(unsigned u) { return __builtin_bit_cast(float, u << 16); }
DI float bfhi(unsigned u) { return __builtin_bit_cast(float, u & 0xffff0000u); }
#define DPP_ADD(v, ctrl) ((v) + __builtin_bit_cast(float, __builtin_amdgcn_update_dpp(0, __builtin_bit_cast(int, (v)), (ctrl), 0xf, 0xf, true)))
DI float row_sum16(float v) {
    v = DPP_ADD(v, 0xB1); v = DPP_ADD(v, 0x4E); v = DPP_ADD(v, 0x141); v = DPP_ADD(v, 0x140); return v;
}
DI float rdlane(float v, int l) { return __builtin_bit_cast(float, __builtin_amdgcn_readlane(__builtin_bit_cast(int, v), l)); }
DI float wave_sum(float v) {
    v = row_sum16(v);
    return (rdlane(v, 0) + rdlane(v, 16)) + (rdlane(v, 32) + rdlane(v, 48));
}
DI float half_sum(float v) {
    v = row_sum16(v);
    const float a = rdlane(v, 0) + rdlane(v, 16), b = rdlane(v, 32) + rdlane(v, 48);
    return (threadIdx.x & 32) ? b : a;
}
DI float fexp2(float x) { return __builtin_amdgcn_exp2f(x); }
DI float flog2(float x) { return __builtin_amdgcn_logf(x); }
DI float frcp(float x) { return __builtin_amdgcn_rcpf(x); }
DI float silu_f(float v) { return v * frcp(1.f + fexp2(-1.4426950408889634f * v)); }
DI float gelu_tanh_f(float v) { const float u = v * (1.f + 0.044715f * v * v); return v * frcp(1.f + fexp2(-2.302208198f * u)); }
#define MFMA32(a, b, c) __builtin_amdgcn_mfma_f32_32x32x16_bf16((a), (b), (c), 0, 0, 0)
DI int crow(int i, int hh) { return (i & 3) + 8 * (i >> 2) + 4 * hh; }
DI int pi32(int m) { return (m & 0x13) | ((m & 8) >> 1) | ((m & 4) << 1); }
DI bf16x8 ld8_bf(const bf16* p) { return *(const bf16x8*)p; }
DI bf16x8 ld8_f32(const float* p) { const f32x4 a = *(const f32x4*)p, b = *(const f32x4*)(p + 4); u32x4 r = {pk2(a.x, a.y), pk2(a.z, a.w), pk2(b.x, b.y), pk2(b.z, b.w)}; return __builtin_bit_cast(bf16x8, r); }
DI bf16x8 pack8(float a0, float a1, float a2, float a3, float a4, float a5, float a6, float a7) { u32x4 r = {pk2(a0, a1), pk2(a2, a3), pk2(a4, a5), pk2(a6, a7)}; return __builtin_bit_cast(bf16x8, r); }
DI f32x16 zero16() { f32x16 z;
#pragma unroll
    for (int i = 0; i < 16; ++i) z[i] = 0.f; return z; }

#define XB_TMO      128
#define XB_XCNT(j)  (256  + 64 * (j))
#define XB_XSUB(j)  (1280 + 64 * (j))
#define XB_XGEN(j)  (2304 + 64 * (j))
#define XB_TOP      3328
#define XB_TOPGEN   3392
#define XCD_BAR_WORDS 3456
#define XB_SPIN_CAP (1u << 18)

__device__ __forceinline__ unsigned xb_ld(unsigned* p)              { return __hip_atomic_load(p, __ATOMIC_RELAXED, __HIP_MEMORY_SCOPE_AGENT); }
__device__ __forceinline__ unsigned xb_add(unsigned* p, unsigned v) { return __hip_atomic_fetch_add(p, v, __ATOMIC_RELAXED, __HIP_MEMORY_SCOPE_AGENT); }
__device__ __forceinline__ unsigned xb_xcc_id() { return (unsigned)__builtin_amdgcn_s_getreg((3 << 11) | 20) & 0xFu; }
#define XB_SPIN(cond, bar) do { unsigned _sp = 0; while (cond) { __builtin_amdgcn_s_sleep(1); \
    if ((++_sp & 255u) == 0u) { if (xb_ld(&(bar)[XB_TMO])) break; if (_sp > XB_SPIN_CAP) { atomicAdd(&(bar)[XB_TMO], 1u); break; } } } } while (0)

struct XcdBarrier {
    unsigned* bar; unsigned x;
    volatile __attribute__((address_space(3))) unsigned* st;
};

__device__ __forceinline__ XcdBarrier xcd_barrier_post(unsigned* bar, volatile __attribute__((address_space(3))) unsigned* st) {
    XcdBarrier b; b.bar = bar; b.x = xb_xcc_id(); b.st = st;
    if (threadIdx.x == 0) (void)xb_add(&bar[XB_XCNT(b.x)], 1u);
    return b;
}
__device__ __forceinline__ void xcd_barrier_complete(unsigned* bar, unsigned x, unsigned& nloc, unsigned& nx) {
    const unsigned G = gridDim.x * gridDim.y * gridDim.z;
    unsigned sum, cnt, mine, sp = 0u;
    for (;;) {
        sum = 0u; cnt = 0u; mine = 0u;
#pragma unroll
        for (unsigned j = 0; j < 16; ++j) { const unsigned c = xb_ld(&bar[XB_XCNT(j)]); sum += c; cnt += (c > 0u) ? 1u : 0u; mine = (j == x) ? c : mine; }
        if (sum == G) break;
        __builtin_amdgcn_s_sleep(1);
        if ((++sp & 255u) == 0u) { if (xb_ld(&bar[XB_TMO])) break; if (sp > XB_SPIN_CAP) { atomicAdd(&bar[XB_TMO], 1u); break; } }
    }
    nloc = mine > 0u ? mine : 1u; nx = cnt > 0u ? cnt : 1u;
}

__device__ __forceinline__ void xcd_barrier(const XcdBarrier& b) {
    asm volatile("s_waitcnt vmcnt(0)" ::: "memory");
    __syncthreads();
    if (threadIdx.x == 0) {
        unsigned* bar = b.bar;
        __builtin_amdgcn_s_waitcnt(0);
        unsigned nloc = b.st[0], nx = b.st[1];
        if (nloc == 0u) { xcd_barrier_complete(bar, b.x, nloc, nx); b.st[0] = nloc; b.st[1] = nx; }
        const unsigned old = xb_add(&bar[XB_XSUB(b.x)], 1u);
        const unsigned gen = old / nloc;
        if (old + 1u == (gen + 1u) * nloc) {
            __builtin_amdgcn_fence(__ATOMIC_RELEASE, "agent");
            asm volatile("s_waitcnt vmcnt(0)" ::: "memory");
            const unsigned og = xb_add(&bar[XB_TOP], 1u);
            const unsigned tg = og / nx;
            if (og + 1u == (tg + 1u) * nx) xb_add(&bar[XB_TOPGEN], 1u);
            else XB_SPIN(xb_ld(&bar[XB_TOPGEN]) == tg, bar);
            __builtin_amdgcn_fence(__ATOMIC_ACQUIRE, "agent");
            xb_add(&bar[XB_XGEN(b.x)], 1u);
            asm volatile("s_waitcnt vmcnt(0)" ::: "memory");
        } else {
            XB_SPIN(xb_ld(&bar[XB_XGEN(b.x)]) == gen, bar);
            __builtin_amdgcn_fence(__ATOMIC_ACQUIRE, "agent");
            asm volatile("s_waitcnt vmcnt(0)" ::: "memory");
        }
    }
    __syncthreads();
}

struct EpiF32 {
    static constexpr bool PERM = true, AFTER_DRAIN = false;
    float* O; int ldc;
    DI void operator()(const pg8::f32x4 (&acc)[2][2][4][2], const pg8::Unit& u, int wr, int wc, int fr, int fq) const {
        const int row0 = u.pm * 256 + wr * 64 + fr, col0 = u.pn * 256 + wc * 32 + 8 * fq;
#pragma unroll
        for (int ai = 0; ai < 2; ++ai)
#pragma unroll
            for (int m = 0; m < 4; ++m) { float* rp = O + (size_t)(row0 + ai * 128 + m * 16) * ldc + col0;
#pragma unroll
                for (int bj = 0; bj < 2; ++bj) { *(f32x4*)(rp + bj * 128) = acc[ai][bj][m][0]; *(f32x4*)(rp + bj * 128 + 4) = acc[ai][bj][m][1]; } }
    }
};
struct EpiF32Split {
    static constexpr bool PERM = true, AFTER_DRAIN = false;
    float* O;
    DI void operator()(const pg8::f32x4 (&acc)[2][2][4][2], const pg8::Unit& u, int wr, int wc, int fr, int fq) const {
        const int ks = u.pn >> 2, pn = u.pn & 3; const int row0 = u.pm * 256 + wr * 64 + fr, col0 = pn * 256 + wc * 32 + 8 * fq;
        float* base = O + (size_t)ks * MS * DM;
#pragma unroll
        for (int ai = 0; ai < 2; ++ai)
#pragma unroll
            for (int m = 0; m < 4; ++m) { float* rp = base + (size_t)(row0 + ai * 128 + m * 16) * DM + col0;
#pragma unroll
                for (int bj = 0; bj < 2; ++bj) { *(f32x4*)(rp + bj * 128) = acc[ai][bj][m][0]; *(f32x4*)(rp + bj * 128 + 4) = acc[ai][bj][m][1]; } }
    }
};
struct EpiInProj {
    static constexpr bool PERM = true, AFTER_DRAIN = false;
    unsigned char* ws; float* out;
    DI void operator()(const pg8::f32x4 (&acc)[2][2][4][2], const pg8::Unit& u, int wr, int wc, int fr, int fq) const {
        const int row0 = u.pm * 256 + wr * 64 + fr; const int pn = u.pn;
        bf16* dst; int ldd, colb; float* fo_p = nullptr; float* fo_s = nullptr;
        if (pn < 8) { const int t = pn >> 1; dst = (bf16*)(ws + WS_Q + (size_t)t * (WS_K - WS_Q)); ldd = 512; colb = (pn & 1) * 256 + wc * 32 + 8 * fq;
            if (t == 1) { fo_p = out + O_KP; fo_s = out + O_KS; } else if (t == 2) { fo_p = out + O_VP; fo_s = out + O_VS; } }
        else { dst = (bf16*)(ws + WS_XBC); ldd = CONVD; colb = (pn - 8) * 256 + wc * 32 + 8 * fq; }
#pragma unroll
        for (int ai = 0; ai < 2; ++ai)
#pragma unroll
            for (int m = 0; m < 4; ++m) { const int row = row0 + ai * 128 + m * 16;
#pragma unroll
                for (int bj = 0; bj < 2; ++bj) { const pg8::f32x4 v0 = acc[ai][bj][m][0], v1 = acc[ai][bj][m][1]; const int col = colb + bj * 128;
                    u32x4 w = {pk2(v0[0], v0[1]), pk2(v0[2], v0[3]), pk2(v1[0], v1[1]), pk2(v1[2], v1[3])};
                    *(u32x4*)(dst + (size_t)row * ldd + col) = w;
                    if (fo_p) { float* fp = (row < MP) ? fo_p + (size_t)row * 512 + col : fo_s + (size_t)(row - MP) * 512 + col; *(f32x4*)fp = v0; *(f32x4*)(fp + 4) = v1; }
                    if (pn >= 8) {
                        float* fp = nullptr;
                        if (row < MP) { const int t = row & (LP - 1); if (t >= LP - 3) fp = out + O_CSP + ((size_t)(row >> 11) * 3 + (t - (LP - 3))) * CONVD + col; }
                        else { const int rr = row - MP, t = rr & (LS - 1); if (t >= LS - 3) fp = out + O_CSS + ((size_t)(rr >> 5) * 3 + (t - (LS - 3))) * CONVD + col; }
                        if (fp) { *(f32x4*)fp = v0; *(f32x4*)(fp + 4) = v1; } } } }
    }
};
struct EpiUp {
    static constexpr bool PERM = true, AFTER_DRAIN = false;
    bf16* G; bf16* U; float* out;
    DI void operator()(const pg8::f32x4 (&acc)[2][2][4][2], const pg8::Unit& u, int wr, int wc, int fr, int fq) const {
        const int row0 = u.pm * 256 + wr * 64 + fr, col = u.pn * 128 + wc * 32 + 8 * fq;
#pragma unroll
        for (int ai = 0; ai < 2; ++ai)
#pragma unroll
            for (int m = 0; m < 4; ++m) { const int row = row0 + ai * 128 + m * 16;
#pragma unroll
                for (int bj = 0; bj < 2; ++bj) { const pg8::f32x4 v0 = acc[ai][bj][m][0], v1 = acc[ai][bj][m][1];
                    u32x4 w = {pk2(v0[0], v0[1]), pk2(v0[2], v0[3]), pk2(v1[0], v1[1]), pk2(v1[2], v1[3])};
                    *(u32x4*)((bj ? U : G) + (size_t)row * DFF + col) = w;
                    if (bj == 0) {
                        float* fp = nullptr;
                        if (row < MP) { const int t = row & (LP - 1); if (t >= LP - 2) fp = out + O_CFP + ((size_t)(row >> 11) * 2 + (t - (LP - 2))) * DFF + col; }
                        else { const int rr = row - MP, t = rr & (LS - 1); if (t >= LS - 2) fp = out + O_CFS + ((size_t)(rr >> 5) * 2 + (t - (LS - 2))) * DFF + col; }
                        if (fp) { *(f32x4*)fp = v0; *(f32x4*)(fp + 4) = v1; } } } }
    }
};

DI void p0_transpose_item(const float* W, int ldw, int K, bf16* WT, int dst_row0, int k0, int n0, LAS float* scr, int lane) {
#pragma unroll 8
    for (int i = 0; i < 32; ++i) { const int kk = 2 * i + (lane >> 5); scr[kk * 33 + (lane & 31)] = W[(size_t)(k0 + kk) * ldw + n0 + (lane & 31)]; }
    asm volatile("s_waitcnt lgkmcnt(0)" ::: "memory");
    const int c = lane & 7;
#pragma unroll
    for (int j = 0; j < 4; ++j) { const int n = (lane >> 3) + 8 * j; const LAS float* s = scr + (8 * c) * 33 + n;
        u32x4 o = {pk2(s[0 * 33], s[1 * 33]), pk2(s[2 * 33], s[3 * 33]), pk2(s[4 * 33], s[5 * 33]), pk2(s[6 * 33], s[7 * 33])};
        *(u32x4*)(WT + (size_t)(dst_row0 + n) * K + k0 + 8 * c) = o; }
    asm volatile("s_waitcnt lgkmcnt(0)" ::: "memory");
}
NOINL void phase_prologue(PARAMS_T p, LAS unsigned char* lds) {
    const int tid = threadIdx.x, lane = tid & 63, wave = __builtin_amdgcn_readfirstlane(tid >> 6);
    const int gw = blockIdx.x * 8 + wave, NGW = gridDim.x * 8;
    LAS float* scr = (LAS float*)(lds + wave * 8448);
    LAS float* wdt = (LAS float*)(lds + 8 * 8448);
    const float* w_in = p.in[9];
    for (int k = tid; k < DM; k += 512) { const f32x4 a = *(const f32x4*)(w_in + (size_t)k * DIN + NPROJ), b = *(const f32x4*)(w_in + (size_t)k * DIN + NPROJ + 4);
        wdt[0 * DM + k] = a.x; wdt[1 * DM + k] = a.y; wdt[2 * DM + k] = a.z; wdt[3 * DM + k] = a.w; wdt[4 * DM + k] = b.x; wdt[5 * DM + k] = b.y; wdt[6 * DM + k] = b.z; wdt[7 * DM + k] = b.w; }
    constexpr int I_IN = 16 * 88, I_OUT = 16 * 32, I_UP = 16 * 176, I_DN = 44 * 32, NITEMS = I_IN + I_OUT + I_UP + I_DN;
    for (int it = gw; it < NITEMS; it += NGW) {
        int r = it;
        if (r < I_IN) { const int kb = r / 88, nb = r % 88; p0_transpose_item(w_in, DIN, DM, (bf16*)(p.ws + WS_WIN), 32 * nb, 64 * kb, 32 * nb, scr, lane); continue; } r -= I_IN;
        if (r < I_OUT) { const int kb = r / 32, nb = r % 32; p0_transpose_item(p.in[17], DM, DM, (bf16*)(p.ws + WS_WOUT), 32 * nb, 64 * kb, 32 * nb, scr, lane); continue; } r -= I_OUT;
        if (r < I_UP) { const int kb = r / 176, nb = r % 176, n0 = 32 * nb, isup = n0 >= DFF, j = n0 - isup * DFF;
            p0_transpose_item(p.in[20], NUP, DM, (bf16*)(p.ws + WS_WUP), (j >> 7) * 256 + isup * 128 + (j & 127), 64 * kb, n0, scr, lane); continue; } r -= I_UP;
        { const int kb = r / 32, nb = r % 32; p0_transpose_item(p.in[23], DM, DFF, (bf16*)(p.ws + WS_WDN), 32 * nb, 64 * kb, 32 * nb, scr, lane); }
    }
    __syncthreads();
    const float* g = p.in[7];
    f32x4 gv[4];
#pragma unroll
    for (int j = 0; j < 4; ++j) gv[j] = *(const f32x4*)(g + 4 * lane + 256 * j);
    for (int row = gw; row < MT; row += NGW) {
        const float* xr = (row < MP) ? p.in[0] + (size_t)row * DM : p.in[1] + (size_t)(row - MP) * DM;
        f32x4 v[4]; float s = 0.f;
#pragma unroll
        for (int j = 0; j < 4; ++j) { v[j] = *(const f32x4*)(xr + 4 * lane + 256 * j); s += (v[j].x * v[j].x + v[j].y * v[j].y) + (v[j].z * v[j].z + v[j].w * v[j].w); }
        const float rstd = __builtin_amdgcn_rsqf(wave_sum(s) * (1.f / DM) + EPS);
#pragma unroll
        for (int j = 0; j < 4; ++j) v[j] = v[j] * rstd * gv[j];
        bf16* orow = (bf16*)(p.ws + WS_A16) + (size_t)row * DM;
#pragma unroll
        for (int j = 0; j < 4; ++j) { u32x2 o = {pk2(v[j].x, v[j].y), pk2(v[j].z, v[j].w)}; *(u32x2*)(orow + 4 * lane + 256 * j) = o; }
        float d[8];
#pragma unroll
        for (int q = 0; q < 8; ++q) { float a = 0.f;
#pragma unroll
            for (int j = 0; j < 4; ++j) { const f32x4 w = *(const LAS f32x4*)(wdt + q * DM + 4 * lane + 256 * j); a += (v[j].x * w.x + v[j].y * w.y) + (v[j].z * w.z + v[j].w * w.w); }
            d[q] = wave_sum(a); }
        if (lane == 0) { float* dp = (float*)(p.ws + WS_DT) + (size_t)row * 8; *(f32x4*)dp = (f32x4){d[0], d[1], d[2], d[3]}; *(f32x4*)(dp + 4) = (f32x4){d[4], d[5], d[6], d[7]}; }
    }
}

constexpr float ATT_C2 = 0.125f * 1.4426950408889634f;
constexpr float ATT_EXIT = 92.f;
constexpr int VS_PITCH = 68;

template <bool F32>
DI void attn_step(const void* Kp, const void* Vp, int nrows, int kbase, int q_abs, const bf16x8 (&qf)[4], f32x16 (&o)[2], float& R, LAS bf16* vs, int lane) {
    const int r = lane & 31, hh = lane >> 5;
    int krow = pi32(r); krow = krow < nrows ? krow : nrows - 1;
    bf16x8 kf[4];
#pragma unroll
    for (int s = 0; s < 4; ++s) { const size_t off = (size_t)krow * 512 + 16 * s + 8 * hh; kf[s] = F32 ? ld8_f32((const float*)Kp + off) : ld8_bf((const bf16*)Kp + off); }
#pragma unroll
    for (int i = 0; i < 4; ++i) { const int key = (lane & 7) + 8 * i, dch = lane >> 3; const int kr = key < nrows ? key : nrows - 1; const size_t off = (size_t)kr * 512 + dch * 8;
        const bf16x8 v = F32 ? ld8_f32((const float*)Vp + off) : ld8_bf((const bf16*)Vp + off); const u32x4 vu = __builtin_bit_cast(u32x4, v);
        LAS u32x2* d = (LAS u32x2*)(vs + key * VS_PITCH + dch * 8); d[0] = (u32x2){vu.x, vu.y}; d[1] = (u32x2){vu.z, vu.w}; }
    f32x16 st = zero16();
#pragma unroll
    for (int s = 0; s < 4; ++s) st = MFMA32(kf[s], qf[s], st);
    float z[16], c[16]; bool valid[16];
#pragma unroll
    for (int i = 0; i < 16; ++i) { const int key = kbase + 16 * (i >> 3) + 8 * hh + (i & 7); valid[i] = key < q_abs; z[i] = st[i] * ATT_C2;
        const float sp = fmaxf(z[i], 0.f) + flog2(1.f + fexp2(-fabsf(z[i]))); c[i] = valid[i] ? sp : 0.f; }
#pragma unroll
    for (int i = 6; i >= 0; --i) { c[i] += c[i + 1]; c[8 + i] += c[8 + i + 1]; }
    const float g0 = c[0], g1 = c[8], og0 = __shfl_xor(g0, 32), og1 = __shfl_xor(g1, 32);
    const float b1 = R + (hh ? 0.f : og1), b0 = R + (hh ? (og1 + g1) : (og0 + g1 + og1));
    float w[16];
#pragma unroll
    for (int i = 0; i < 16; ++i) { const float e = fexp2(z[i] - (c[i] + (i < 8 ? b0 : b1))); w[i] = valid[i] ? e : 0.f; }
    R += (g0 + g1) + (og0 + og1);
    const bf16x8 pf0 = pack8(w[0], w[1], w[2], w[3], w[4], w[5], w[6], w[7]), pf1 = pack8(w[8], w[9], w[10], w[11], w[12], w[13], w[14], w[15]);
#pragma unroll
    for (int s = 0; s < 2; ++s)
#pragma unroll
        for (int db = 0; db < 2; ++db) { const LAS bf16* vp = vs + (16 * s + 8 * hh) * VS_PITCH + r + 32 * db;
            bf16x8 vf;
#pragma unroll
            for (int j = 0; j < 8; ++j) vf[j] = (short)vp[j * VS_PITCH];
            o[db] = MFMA32(s ? pf1 : pf0, vf, o[db]); }
}

template <bool SAMPLE>
NOINL void attn_item(PARAMS_T p, int b, int qblk, LAS unsigned char* lds) {
    const int tid = threadIdx.x, lane = tid & 63, head = __builtin_amdgcn_readfirstlane(tid >> 6), r = lane & 31, hh = lane >> 5;
    LAS bf16* vs = (LAS bf16*)(lds + head * (32 * VS_PITCH * 2));
    LAS float* red = (LAS float*)(lds + 8 * (32 * VS_PITCH * 2));
    LAS float* rs = red + 256;
    const bf16* Qb = (const bf16*)(p.ws + WS_Q); const bf16* Kb = (const bf16*)(p.ws + WS_K); const bf16* Vb = (const bf16*)(p.ws + WS_V);
    const int tok0 = SAMPLE ? (MP + b * LS) : (b * LP + qblk * 32);
    bf16x8 qf[4];
#pragma unroll
    for (int s = 0; s < 4; ++s) qf[s] = ld8_bf(Qb + (size_t)(tok0 + r) * 512 + head * 64 + 16 * s + 8 * hh);
    f32x16 o[2]; o[0] = zero16(); o[1] = zero16();
    float R = 0.f;
    const int q_abs = SAMPLE ? (PAST + r) : (qblk * 32 + r);
    if (SAMPLE) {
        attn_step<false>(Kb + (size_t)tok0 * 512 + head * 64, Vb + (size_t)tok0 * 512 + head * 64, 32, PAST, q_abs, qf, o, R, vs, lane);
        const float* ck = p.in[2] + (size_t)b * PAST * 512 + head * 64; const float* cv = p.in[3] + (size_t)b * PAST * 512 + head * 64;
        for (int j = 1; j <= PAST / 32; ++j) {
            if (__ballot(R < ATT_EXIT) == 0ull) break;
            const int kbase = PAST - 32 * j;
            attn_step<true>(ck + (size_t)kbase * 512, cv + (size_t)kbase * 512, 32, kbase, q_abs, qf, o, R, vs, lane);
        }
    } else {
        for (int j = qblk; j >= 0; --j) {
            const size_t ro = (size_t)(b * LP + j * 32) * 512 + head * 64;
            attn_step<false>(Kb + ro, Vb + ro, 32, j * 32, q_abs, qf, o, R, vs, lane);
            if (__ballot(R < ATT_EXIT) == 0ull) break;
        }
    }
    float ss[16];
#pragma unroll
    for (int i = 0; i < 16; ++i) ss[i] = half_sum(o[0][i] * o[0][i] + o[1][i] * o[1][i]);
    if (r == 0) {
#pragma unroll
        for (int i = 0; i < 16; ++i) red[head * 32 + crow(i, hh)] = ss[i]; }
    __syncthreads();
    if (tid < 32) { float a = 0.f;
#pragma unroll
        for (int w = 0; w < 8; ++w) a += red[w * 32 + tid];
        rs[tid] = __builtin_amdgcn_rsqf(a * (1.f / 512.f) + EPS); }
    __syncthreads();
    const float* ga = p.in[16];
    const float g0 = ga[head * 64 + r], g1 = ga[head * 64 + 32 + r];
    bf16* mix = (bf16*)(p.ws + WS_A16);
#pragma unroll
    for (int i = 0; i < 16; ++i) { const int q = crow(i, hh); const float sc = rs[q]; bf16* mp = mix + (size_t)(tok0 + q) * DM + head * 64 + r;
        mp[0] = (bf16)(pk2(o[0][i] * sc * g0, 0.f) & 0xffffu); mp[32] = (bf16)(pk2(o[1][i] * sc * g1, 0.f) & 0xffffu); }
    __syncthreads();
}

constexpr int NCHUNK = NBP * NCH + NBS;
NOINL void phase_conv(PARAMS_T p) {
    const int lane = threadIdx.x & 63, gw = blockIdx.x * 8 + (threadIdx.x >> 6), NGW = gridDim.x * 8;
    const bf16* XBC = (const bf16*)(p.ws + WS_XBC); bf16* TR = (bf16*)(p.ws + WS_TR); bf16* NAT = (bf16*)(p.ws + WS_NAT);
    const float* cw = p.in[10]; const float* cb = p.in[11];
    for (int task = gw; task < NCHUNK * 48; task += NGW) {
        const int cgp = task % 12, t16 = (task / 12) & 3, chunk = task / 48;
        const bool sample = chunk >= NBP * NCH; const int bs = chunk - NBP * NCH;
        const int tok0 = sample ? MP + LS * bs : chunk * 64, nvalid = sample ? LS : 64, tbase = t16 * 16, ch = cgp * 64 + lane;
        float y[16];
        if (tbase >= nvalid) {
#pragma unroll
            for (int j = 0; j < 16; ++j) y[j] = 0.f;
        } else {
            float xr[19];
            const bf16* xp = XBC + (size_t)(tok0 + tbase) * CONVD + ch;
#pragma unroll
            for (int k = 3; k < 19; ++k) xr[k] = bf2f(xp[(size_t)(k - 3) * CONVD]);
            if (tbase > 0 || (!sample && (chunk & (NCH - 1)) != 0)) {
#pragma unroll
                for (int k = 0; k < 3; ++k) xr[k] = bf2f(xp[(ptrdiff_t)(k - 3) * CONVD]);
            } else if (sample) {
#pragma unroll
                for (int k = 0; k < 3; ++k) xr[k] = p.in[5][((size_t)bs * 3 + k) * CONVD + ch];
            } else { xr[0] = 0.f; xr[1] = 0.f; xr[2] = 0.f; }
            const float w0 = cw[ch], w1 = cw[CONVD + ch], w2 = cw[2 * CONVD + ch], w3 = cw[3 * CONVD + ch], bi = cb[ch];
#pragma unroll
            for (int j = 0; j < 16; ++j) y[j] = silu_f(bi + w0 * xr[j] + w1 * xr[j + 1] + w2 * xr[j + 2] + w3 * xr[j + 3]);
        }
        if (ch < 640) { bf16* tp = TR + ((size_t)chunk * 640 + ch) * 64 + tbase;
            *(bf16x8*)tp = pack8(y[0], y[1], y[2], y[3], y[4], y[5], y[6], y[7]); *(bf16x8*)(tp + 8) = pack8(y[8], y[9], y[10], y[11], y[12], y[13], y[14], y[15]); }
        if (ch >= 512) { bf16* np = NAT + ((size_t)chunk * 64 + tbase) * 256 + (ch - 512);
#pragma unroll
            for (int j = 0; j < 16; ++j) np[j * 256] = (bf16)(pk2(y[j], 0.f) & 0xffffu); }
    }
}

constexpr int SSD_W = 0, SSD_RED = 8 * 768, SSD_RS = SSD_RED + 2048;
DI void unpack8s(const bf16x8 v, float (&f)[8]) { const u32x4 u = __builtin_bit_cast(u32x4, v); f[0] = bflo(u.x); f[1] = bfhi(u.x); f[2] = bflo(u.y); f[3] = bfhi(u.y); f[4] = bflo(u.z); f[5] = bfhi(u.z); f[6] = bflo(u.w); f[7] = bfhi(u.w); }
template <bool PH3>
NOINL void ssd_item(PARAMS_T p, int chunk, LAS unsigned char* lds) {
    const int tid = threadIdx.x, lane = tid & 63, h = __builtin_amdgcn_readfirstlane(tid >> 6), r = lane & 31, hh = lane >> 5, g = h >> 2;
    const bool sample = chunk >= NBP * NCH; const int bs = chunk - NBP * NCH;
    const int tok0 = sample ? MP + LS * bs : chunk * 64, nvalid = sample ? LS : 64;
    LAS float* dtw = (LAS float*)(lds + SSD_W + h * 768); LAS float* acw = dtw + 64; LAS float* exw = dtw + 128;
    LAS float* red = (LAS float*)(lds + SSD_RED); LAS float* rs = (LAS float*)(lds + SSD_RS);
    const bf16* TR = (const bf16*)(p.ws + WS_TR) + (size_t)chunk * 640 * 64; const bf16* NAT = (const bf16*)(p.ws + WS_NAT) + (size_t)chunk * 64 * 256;
    const float a_h = -expf(p.in[13][h]);
    float dt = 0.f;
    if (lane < nvalid) { const float x = ((const float*)(p.ws + WS_DT))[(size_t)(tok0 + lane) * 8 + h] + p.in[12][h]; dt = x > 20.f ? x : log1pf(expf(x)); }
    float ac = dt * a_h;
#pragma unroll
    for (int o = 1; o < 64; o <<= 1) { const float t = __shfl_up(ac, o); if (lane >= o) ac += t; }
    const float atot = __shfl(ac, 63);
    dtw[lane] = dt; acw[lane] = ac; exw[lane] = PH3 ? expf(ac) : expf(atot - ac) * dt;
    if (!PH3) {
        f32x16 st[2][2];
#pragma unroll
        for (int i = 0; i < 2; ++i)
#pragma unroll
            for (int j = 0; j < 2; ++j) st[i][j] = zero16();
#pragma unroll
        for (int ks = 0; ks < 4; ++ks) { bf16x8 a[2], bb[2]; float wv[8];
#pragma unroll
            for (int j = 0; j < 8; ++j) wv[j] = exw[16 * ks + 8 * hh + j];
#pragma unroll
            for (int i = 0; i < 2; ++i) { float xf[8]; unpack8s(ld8_bf(TR + (size_t)(h * 64 + r + 32 * i) * 64 + 16 * ks + 8 * hh), xf);
                a[i] = pack8(xf[0] * wv[0], xf[1] * wv[1], xf[2] * wv[2], xf[3] * wv[3], xf[4] * wv[4], xf[5] * wv[5], xf[6] * wv[6], xf[7] * wv[7]);
                bb[i] = ld8_bf(TR + (size_t)(512 + g * 64 + r + 32 * i) * 64 + 16 * ks + 8 * hh); }
#pragma unroll
            for (int i = 0; i < 2; ++i)
#pragma unroll
                for (int j = 0; j < 2; ++j) st[i][j] = MFMA32(a[i], bb[j], st[i][j]); }
        if (sample) {
            const float dec = expf(atot); const float* h0p = p.in[4] + (size_t)(bs * NH + h) * 4096; float* op = p.out + O_HS + (size_t)(bs * NH + h) * 4096;
#pragma unroll
            for (int pb = 0; pb < 2; ++pb)
#pragma unroll
                for (int nb = 0; nb < 2; ++nb)
#pragma unroll
                    for (int i = 0; i < 16; ++i) { const int idx = (crow(i, hh) + 32 * pb) * 64 + r + 32 * nb; op[idx] = dec * h0p[idx] + st[pb][nb][i]; }
        } else {
            float* sp = (float*)(p.ws + WS_ST) + (size_t)(chunk * NH + h) * 4096;
#pragma unroll
            for (int pb = 0; pb < 2; ++pb)
#pragma unroll
                for (int nb = 0; nb < 2; ++nb)
#pragma unroll
                    for (int i = 0; i < 16; ++i) sp[(crow(i, hh) + 32 * pb) * 64 + r + 32 * nb] = st[pb][nb][i];
            if (lane == 0) ((float*)(p.ws + WS_DEC))[chunk * NH + h] = expf(atot);
        }
    } else {
        const float* Hin = sample ? p.in[4] + (size_t)(bs * NH + h) * 4096 : (const float*)(p.ws + WS_ST) + (size_t)(chunk * NH + h) * 4096;
        f32x16 acc[2][2];
#pragma unroll
        for (int i = 0; i < 2; ++i)
#pragma unroll
            for (int j = 0; j < 2; ++j) acc[i][j] = zero16();
        bf16x8 cf[2][4];
#pragma unroll
        for (int tb = 0; tb < 2; ++tb)
#pragma unroll
            for (int ks = 0; ks < 4; ++ks) cf[tb][ks] = ld8_bf(NAT + (size_t)(r + 32 * tb) * 256 + 128 + g * 64 + 16 * ks + 8 * hh);
#pragma unroll
        for (int ks = 0; ks < 4; ++ks) { bf16x8 bb[2];
#pragma unroll
            for (int i = 0; i < 2; ++i) bb[i] = ld8_f32(Hin + (size_t)(r + 32 * i) * 64 + 16 * ks + 8 * hh);
#pragma unroll
            for (int i = 0; i < 2; ++i)
#pragma unroll
                for (int j = 0; j < 2; ++j) acc[i][j] = MFMA32(cf[i][ks], bb[j], acc[i][j]); }
#pragma unroll
        for (int tb = 0; tb < 2; ++tb)
#pragma unroll
            for (int i = 0; i < 16; ++i) { const float e = exw[crow(i, hh) + 32 * tb]; acc[tb][0][i] *= e; acc[tb][1][i] *= e; }
        const float Dh = p.in[14][h];
#pragma unroll
        for (int tb = 0; tb < 2; ++tb) {
            const int t = r + 32 * tb; const float at = acw[t];
#pragma unroll
            for (int sb = 0; sb <= tb; ++sb) {
                __builtin_amdgcn_sched_barrier(0);
                f32x16 cbt = zero16();
#pragma unroll
                for (int ks = 0; ks < 4; ++ks) { const bf16x8 a = ld8_bf(NAT + (size_t)(pi32(r) + 32 * sb) * 256 + g * 64 + 16 * ks + 8 * hh); cbt = MFMA32(a, cf[tb][ks], cbt); }
                float mv[16];
#pragma unroll
                for (int i = 0; i < 16; ++i) { const int s = 32 * sb + 16 * (i >> 3) + 8 * hh + (i & 7); const float e = expf(at - acw[s]) * dtw[s] * cbt[i]; mv[i] = (s <= t) ? e : 0.f; if (s == t) mv[i] += Dh; }
                const bf16x8 pf0 = pack8(mv[0], mv[1], mv[2], mv[3], mv[4], mv[5], mv[6], mv[7]), pf1 = pack8(mv[8], mv[9], mv[10], mv[11], mv[12], mv[13], mv[14], mv[15]);
#pragma unroll
                for (int ks2 = 0; ks2 < 2; ++ks2)
#pragma unroll
                    for (int pb = 0; pb < 2; ++pb) { const bf16x8 bb = ld8_bf(TR + (size_t)(h * 64 + r + 32 * pb) * 64 + 32 * sb + 16 * ks2 + 8 * hh); acc[tb][pb] = MFMA32(ks2 ? pf1 : pf0, bb, acc[tb][pb]); }
            }
        }
        const bf16* Zb = (const bf16*)(p.ws + WS_Z);
#pragma unroll
        for (int tb = 0; tb < 2; ++tb) {
            __builtin_amdgcn_sched_barrier(0);
            unsigned short zr[16][2];
#pragma unroll
            for (int i = 0; i < 16; ++i) { const int t = crow(i, hh) + 32 * tb; const bf16* zp = Zb + (size_t)(tok0 + (t < nvalid ? t : 0)) * 512 + h * 64 + r; zr[i][0] = zp[0]; zr[i][1] = zp[32]; }
#pragma unroll
            for (int i = 0; i < 16; ++i) { const int t = crow(i, hh) + 32 * tb;
                const float v0 = acc[tb][0][i] * silu_f(bf2f(zr[i][0])), v1 = acc[tb][1][i] * silu_f(bf2f(zr[i][1])); acc[tb][0][i] = v0; acc[tb][1][i] = v1;
                const float s2 = half_sum((t < nvalid) ? v0 * v0 + v1 * v1 : 0.f);
                if (r == 0) red[h * 64 + t] = s2; }
        }
        __builtin_amdgcn_sched_barrier(0);
        __syncthreads();
        if (tid < 64) { float a = 0.f;
#pragma unroll
            for (int w = 0; w < 8; ++w) a += red[w * 64 + tid];
            rs[tid] = __builtin_amdgcn_rsqf(a * (1.f / 512.f) + EPS); }
        __syncthreads();
        const float* gs = p.in[15]; const float g0 = gs[h * 64 + r], g1 = gs[h * 64 + 32 + r];
        bf16* mix = (bf16*)(p.ws + WS_A16);
#pragma unroll
        for (int tb = 0; tb < 2; ++tb)
#pragma unroll
            for (int i = 0; i < 16; ++i) { const int t = crow(i, hh) + 32 * tb;
                if (t < nvalid) { const float sc = rs[t]; bf16* mp = mix + (size_t)(tok0 + t) * DM + 512 + h * 64 + r;
                    mp[0] = (bf16)(pk2(acc[tb][0][i] * sc * g0, 0.f) & 0xffffu); mp[32] = (bf16)(pk2(acc[tb][1][i] * sc * g1, 0.f) & 0xffffu); } }
        __syncthreads();
    }
}

NOINL void phase_scan(PARAMS_T p) {
    const int gid = blockIdx.x * 512 + threadIdx.x;
    if (gid < NBP * NH * 1024) {
        const int bh = gid >> 10, e4 = gid & 1023, b = bh >> 3, h = bh & 7;
        float* st = (float*)(p.ws + WS_ST); const float* dec = (const float*)(p.ws + WS_DEC);
        f32x4 hs = {0.f, 0.f, 0.f, 0.f};
#pragma unroll
        for (int c0 = 0; c0 < NCH; c0 += 16) {
            f32x4 tv[16]; float dv[16];
#pragma unroll
            for (int c = 0; c < 16; ++c) { tv[c] = *((const f32x4*)(st + (size_t)((b * NCH + c0 + c) * NH + h) * 4096) + e4); dv[c] = dec[(b * NCH + c0 + c) * NH + h]; }
#pragma unroll
            for (int c = 0; c < 16; ++c) { *((f32x4*)(st + (size_t)((b * NCH + c0 + c) * NH + h) * 4096) + e4) = hs; hs = hs * dv[c] + tv[c]; }
        }
        *((f32x4*)(p.out + O_HP + (size_t)bh * 4096) + e4) = hs;
    }
}
NOINL void phase_post_mixer(PARAMS_T p) {
    const int lane = threadIdx.x & 63, gw = blockIdx.x * 8 + (threadIdx.x >> 6), NGW = gridDim.x * 8;
    f32x4 g1[4], g2[4];
#pragma unroll
    for (int j = 0; j < 4; ++j) { g1[j] = *(const f32x4*)(p.in[8] + 4 * lane + 256 * j); g2[j] = *(const f32x4*)(p.in[18] + 4 * lane + 256 * j); }
    for (int row = gw; row < MT; row += NGW) {
        const float* xr = (row < MP) ? p.in[0] + (size_t)row * DM : p.in[1] + (size_t)(row - MP) * DM;
        const float* mr = (const float*)(p.ws + WS_M) + (size_t)row * DM;
        f32x4 m[4], x[4]; float s = 0.f;
        if (row >= MP) {
#pragma unroll
            for (int j = 0; j < 4; ++j) { m[j] = (f32x4){0.f, 0.f, 0.f, 0.f};
#pragma unroll
                for (int ks = 0; ks < KS_OUT; ++ks) m[j] += *(const f32x4*)((const float*)(p.ws + WS_MS) + ((size_t)ks * MS + (row - MP)) * DM + 4 * lane + 256 * j); }
        } else {
#pragma unroll
            for (int j = 0; j < 4; ++j) m[j] = *(const f32x4*)(mr + 4 * lane + 256 * j);
        }
#pragma unroll
        for (int j = 0; j < 4; ++j) { x[j] = *(const f32x4*)(xr + 4 * lane + 256 * j); s += (m[j].x * m[j].x + m[j].y * m[j].y) + (m[j].z * m[j].z + m[j].w * m[j].w); }
        const float r1 = __builtin_amdgcn_rsqf(wave_sum(s) * (1.f / DM) + EPS); float s2 = 0.f;
        float* hr = p.out + (size_t)row * DM;
#pragma unroll
        for (int j = 0; j < 4; ++j) { x[j] = x[j] + m[j] * r1 * g1[j]; *(f32x4*)(hr + 4 * lane + 256 * j) = x[j]; s2 += (x[j].x * x[j].x + x[j].y * x[j].y) + (x[j].z * x[j].z + x[j].w * x[j].w); }
        const float r2 = __builtin_amdgcn_rsqf(wave_sum(s2) * (1.f / DM) + EPS);
        bf16* orow = (bf16*)(p.ws + WS_A16) + (size_t)row * DM;
#pragma unroll
        for (int j = 0; j < 4; ++j) { const f32x4 v = x[j] * r2 * g2[j]; u32x2 o = {pk2(v.x, v.y), pk2(v.z, v.w)}; *(u32x2*)(orow + 4 * lane + 256 * j) = o; }
    }
}
NOINL void phase_final(PARAMS_T p) {
    const int lane = threadIdx.x & 63, gw = blockIdx.x * 8 + (threadIdx.x >> 6), NGW = gridDim.x * 8;
    f32x4 g1[4];
#pragma unroll
    for (int j = 0; j < 4; ++j) g1[j] = *(const f32x4*)(p.in[19] + 4 * lane + 256 * j);
    for (int row = gw; row < MT; row += NGW) {
        const float* fr = (const float*)(p.ws + WS_F) + (size_t)row * DM; float* hr = p.out + (size_t)row * DM;
        f32x4 f[4], x[4]; float s = 0.f;
        if (row >= MP) {
#pragma unroll
            for (int j = 0; j < 4; ++j) { f[j] = (f32x4){0.f, 0.f, 0.f, 0.f};
#pragma unroll
                for (int ks = 0; ks < KS_DN; ++ks) f[j] += *(const f32x4*)((const float*)(p.ws + WS_FS) + ((size_t)ks * MS + (row - MP)) * DM + 4 * lane + 256 * j); }
        } else {
#pragma unroll
            for (int j = 0; j < 4; ++j) f[j] = *(const f32x4*)(fr + 4 * lane + 256 * j);
        }
#pragma unroll
        for (int j = 0; j < 4; ++j) { x[j] = *(const f32x4*)(hr + 4 * lane + 256 * j); s += (f[j].x * f[j].x + f[j].y * f[j].y) + (f[j].z * f[j].z + f[j].w * f[j].w); }
        const float r1 = __builtin_amdgcn_rsqf(wave_sum(s) * (1.f / DM) + EPS);
#pragma unroll
        for (int j = 0; j < 4; ++j) *(f32x4*)(hr + 4 * lane + 256 * j) = x[j] + f[j] * r1 * g1[j];
    }
}
DI void unpack8(const u32x4 v, float (&f)[8]) { f[0] = bflo(v.x); f[1] = bfhi(v.x); f[2] = bflo(v.y); f[3] = bfhi(v.y); f[4] = bflo(v.z); f[5] = bfhi(v.z); f[6] = bflo(v.w); f[7] = bfhi(v.w); }
NOINL void phase_act(PARAMS_T p) {
    const bf16* G = (const bf16*)(p.ws + WS_G); bf16* U = (bf16*)(p.ws + WS_U);
    const float* cw = p.in[21]; const float* cb = p.in[22];
    const int total = gridDim.x * 512;
    for (int task = blockIdx.x * 512 + threadIdx.x; task < (MT / 32) * (DFF / 8); task += total) {
        const int run = task / (DFF / 8), col = (task % (DFF / 8)) * 8, row0 = run * 32;
        float w0[8], w1[8], w2[8], bs[8], g2[8], g1[8];
#pragma unroll
        for (int j = 0; j < 8; ++j) { w0[j] = cw[col + j]; w1[j] = cw[DFF + col + j]; w2[j] = cw[2 * DFF + col + j]; bs[j] = cb[col + j]; g2[j] = 0.f; g1[j] = 0.f; }
        if (row0 >= MP) { const float* sp = p.in[6] + (size_t)((row0 - MP) >> 5) * 2 * DFF + col;
#pragma unroll
            for (int j = 0; j < 8; ++j) { g2[j] = sp[j]; g1[j] = sp[DFF + j]; } }
        else if (row0 & (LP - 1)) { unpack8(*(const u32x4*)(G + (size_t)(row0 - 2) * DFF + col), g2); unpack8(*(const u32x4*)(G + (size_t)(row0 - 1) * DFF + col), g1); }
#pragma unroll 4
        for (int t = 0; t < 32; ++t) {
            float g0[8], uu[8], a[8];
            unpack8(*(const u32x4*)(G + (size_t)(row0 + t) * DFF + col), g0); unpack8(*(const u32x4*)(U + (size_t)(row0 + t) * DFF + col), uu);
#pragma unroll
            for (int j = 0; j < 8; ++j) { a[j] = gelu_tanh_f(bs[j] + w0[j] * g2[j] + w1[j] * g1[j] + w2[j] * g0[j]) * uu[j]; g2[j] = g1[j]; g1[j] = g0[j]; }
            u32x4 o = {pk2(a[0], a[1]), pk2(a[2], a[3]), pk2(a[4], a[5]), pk2(a[6], a[7])};
            *(u32x4*)(U + (size_t)(row0 + t) * DFF + col) = o;
        }
    }
}

NOINL void gemm_inproj(PARAMS_T p, LAS unsigned char* lds) {
    const int G = gridDim.x, bx = blockIdx.x;
    pg8::Gemm g{(const pg8::bf16_t*)(p.ws + WS_A16), (const pg8::bf16_t*)(p.ws + WS_WIN), MT, NPROJ, DM, DM}; pg8::StaticOrder S; S.init(MT, NPROJ, G, bx);
    EpiInProj E{p.ws, p.out};
    pg8::gemm_phase<EpiInProj, pg8::StaticOrder, true, true>(lds, g, S, E);
}
NOINL void gemm_up(PARAMS_T p, LAS unsigned char* lds) {
    const int G = gridDim.x, bx = blockIdx.x;
    pg8::Gemm g{(const pg8::bf16_t*)(p.ws + WS_A16), (const pg8::bf16_t*)(p.ws + WS_WUP), MT, NUP, DM, DM}; pg8::StaticOrder S; S.init(MT, NUP, G, bx);
    EpiUp E{(bf16*)(p.ws + WS_G), (bf16*)(p.ws + WS_U), p.out};
    pg8::gemm_phase<EpiUp, pg8::StaticOrder, true, true>(lds, g, S, E);
}
NOINL void gemm_n1024(PARAMS_T p, LAS unsigned char* lds, int which) {
    const int G = gridDim.x, bx = blockIdx.x;
    const pg8::bf16_t* A = (const pg8::bf16_t*)(p.ws + (which ? WS_U : WS_A16)); const pg8::bf16_t* Bt = (const pg8::bf16_t*)(p.ws + (which ? WS_WDN : WS_WOUT));
    const int K = which ? DFF : DM, nS = which ? KS_DN : KS_OUT;
    float* O0 = (float*)(p.ws + (which ? WS_F : WS_M)); float* O1 = (float*)(p.ws + (which ? WS_FS : WS_MS));
#pragma unroll 1
    for (int call = 0; call < 2; ++call) {
        pg8::Gemm g{A, Bt, call ? MS : MP, DM, call ? 256 : K, K};
        pg8::SplitOrder S{call ? MP / 256 : 0, call ? MS / 256 : MP / 256, DM / 256, call ? nS : 1, 256, G, bx};
        EpiF32Split E{call ? O1 : O0};
        pg8::gemm_phase<EpiF32Split, pg8::SplitOrder, true, true>(lds, g, S, E);
    }
}

constexpr int N_PHASES = 12;
__global__ void __launch_bounds__(512, 2) fwd_kernel(Params p_arg) {
    extern __shared__ __attribute__((aligned(16))) unsigned char lds_raw[];
    LAS unsigned char* lds = (LAS unsigned char*)lds_raw;
    PARAMS_T p = *(const __attribute__((address_space(4))) Params*)__builtin_amdgcn_kernarg_segment_ptr();
    cg::grid_group grid = cg::this_grid();
    const int lo = p.ph_lo, hi = p.ph_hi;
#ifndef PH_MASK
#define PH_MASK 0xfff
#endif
#define IN(k) (((PH_MASK >> (k)) & 1) && lo <= (k) && (k) < hi)
#ifdef PROBE_A0
#define STAMP(i) do { if (bx == 0 && threadIdx.x == 0) ((LAS unsigned long long*)(lds + 144000))[i] = __builtin_amdgcn_s_memrealtime(); } while (0)
#else
#define STAMP(i) do { } while (0)
#endif
#define SEAM(k) do { if (IN(k) && IN((k) + 1)) xcd_barrier(bar); STAMP((k) + 1); } while (0)
    const int G = gridDim.x, bx = blockIdx.x;
    volatile LAS unsigned* bst = (volatile LAS unsigned*)(lds + 147000);
    if (threadIdx.x < 2) bst[threadIdx.x] = 0u;
    __syncthreads();
    XcdBarrier bar = xcd_barrier_post((unsigned*)p.ws, bst);
    if (hi > 1000) grid.sync();
    STAMP(0);
    if (IN(0)) phase_prologue(p, lds);
    SEAM(0);
    if (IN(1)) gemm_inproj(p, lds);
    SEAM(1);
    if (IN(2)) {
        phase_conv(p);
        for (int it = bx; it < NBP * (LP / 32); it += G) attn_item<false>(p, it & 7, 63 - (it >> 3), lds);
        for (int it = bx; it < NBS; it += G) attn_item<true>(p, it, 0, lds);
    }
    SEAM(2);
    if (IN(3)) {
        for (int it = bx; it < NCHUNK; it += G) ssd_item<false>(p, it, lds);
        if (bx >= 128 && bx < 128 + NBS) ssd_item<true>(p, NBP * NCH + bx - 128, lds);
    }
    SEAM(3);
    if (IN(4)) phase_scan(p);
    SEAM(4);
    if (IN(5)) { for (int it = bx; it < NBP * NCH; it += G) ssd_item<true>(p, it, lds); }
    SEAM(5);
    if (IN(6)) gemm_n1024(p, lds, 0);
    SEAM(6);
    if (IN(7)) phase_post_mixer(p);
    SEAM(7);
    if (IN(8)) gemm_up(p, lds);
    SEAM(8);
    if (IN(9)) phase_act(p);
    SEAM(9);
    if (IN(10)) gemm_n1024(p, lds, 1);
    SEAM(10);
    if (IN(11)) phase_final(p);
#ifdef PROBE_A0
    if (bx == 0) {
        __syncthreads();
        if (threadIdx.x == 0) ((LAS unsigned long long*)(lds + 144000))[12] = __builtin_amdgcn_s_memrealtime();
        __syncthreads();
        const LAS unsigned long long* ts = (const LAS unsigned long long*)(lds + 144000);
        const float ta = (float)(long long)(ts[PROBE_A1] - ts[PROBE_A0]) * 0.01f, tb = (float)(long long)(ts[PROBE_B1] - ts[PROBE_B0]) * 0.01f;
        if (threadIdx.x == 0) p.out[O_KP] += ta * 0.0005f;
        const float eps1 = 1.f + sqrtf(tb * (PROBE_BS) * 1e-6f);
        for (int i = threadIdx.x; i < NBS * 3 * CONVD; i += 512) p.out[O_CSS + i] *= eps1;
    }
#endif
#undef IN
#undef SEAM
}

#ifndef N_LAUNCHES
#define N_LAUNCHES 1
#endif
extern "C" void kernel_launch(void* const* d_in, const int* in_sizes, int n_in, void* d_out, int out_size, void* d_ws, size_t ws_size, hipStream_t stream) {
    static int grid = 0;
    if (grid == 0) {
        if (n_in != 24 || out_size != (int)O_END || ws_size < WS_NEED) { fprintf(stderr, "kernel_launch: unexpected shapes: n_in %d out %d ws %zu\n", n_in, out_size, ws_size); grid = -1; return; }
        int dev = 0, cus = 0, per_cu = 0;
        (void)hipGetDevice(&dev); (void)hipDeviceGetAttribute(&cus, hipDeviceAttributeMultiprocessorCount, dev);
        if (hipFuncSetAttribute((const void*)fwd_kernel, hipFuncAttributeMaxDynamicSharedMemorySize, LDS_BYTES) != hipSuccess) { fprintf(stderr, "kernel_launch: hipFuncSetAttribute failed\n"); grid = -1; return; }
        if (hipOccupancyMaxActiveBlocksPerMultiprocessor(&per_cu, (const void*)fwd_kernel, 512, LDS_BYTES) != hipSuccess || per_cu < 1) { fprintf(stderr, "kernel_launch: occupancy query says %d\n", per_cu); per_cu = 1; }
        (void)hipGetLastError();
        grid = cus * (per_cu > 1 ? 1 : per_cu);
        if (grid <= 0) grid = 256;
    }
    if (grid < 0) return;
    if (hipMemsetAsync(d_ws, 0, 16384, stream) != hipSuccess) { fprintf(stderr, "kernel_launch: memset failed\n"); return; }
    Params p{};
    for (int i = 0; i < 24; ++i) p.in[i] = (const float*)d_in[i];
    p.out = (float*)d_out; p.ws = (unsigned char*)d_ws;
#if N_LAUNCHES == 1
    p.ph_lo = 0; p.ph_hi = N_PHASES;
    void* args[] = {&p};
    hipError_t e = hipLaunchCooperativeKernel((const void*)fwd_kernel, dim3(grid), dim3(512), args, LDS_BYTES, stream);
    if (e != hipSuccess) fprintf(stderr, "cooperative launch failed: %s (grid %d)\n", hipGetErrorString(e), grid);
#else
    for (int k = 0; k < N_PHASES; ++k) { p.ph_lo = k; p.ph_hi = k + 1; hipLaunchKernelGGL(fwd_kernel, dim3(grid), dim3(512), LDS_BYTES, stream, p); }
#endif
}
```

```cpp
#include <hip/hip_runtime.h>
#include <hip/hip_cooperative_groups.h>
#include <cstdio>
#include <cstdint>
namespace cg = cooperative_groups;
namespace pg8 {
#define PG8_LAS __attribute__((address_space(3)))
typedef unsigned short bf16_t;
typedef short bf16x8 __attribute__((ext_vector_type(8)));
typedef float f32x4 __attribute__((ext_vector_type(4)));
typedef unsigned u32x4 __attribute__((ext_vector_type(4)));
constexpr int BM = 256, BK = 64, HALF = 128, HTB = HALF * BK * 2  , STAGE_BYTES = 8 * HTB, NXCD = 8, WGM = 8;

__host__ __device__ __forceinline__ int lds_byte(int r, int c) { const int st = (r >> 4) * 2 + (c >> 5), rr = r & 15, cc = c & 31, ob = rr * 64 + cc * 2; return st * 1024 + (ob ^ (((ob >> 9) & 1) << 5)); }
__host__ __device__ __forceinline__ void stage_rc(int b, int& R, int& C) { const int st = b / 1024, sb = b % 1024, swz = sb ^ (((sb >> 9) & 1) << 5); R = (st >> 1) * 16 + swz / 64; C = (st & 1) * 32 + (swz % 64) / 2; }
__host__ __device__ __forceinline__ int perm32(int rho) { const int n = rho >> 4, i = rho & 15; return 8 * (i >> 2) + 4 * n + (i & 3); }

struct Unit { int pm, pn; };
struct Gemm { const bf16_t* A; const bf16_t* Bt; int M, N, K, ldk; };

struct StaticOrder {
    int nM, nN, nwg, G, c;
    __host__ __device__ void init(int M, int N, int G_, int c_) { nM = M / BM; nN = N / BM; nwg = nM * nN; G = G_; c = c_; }
    __host__ __device__ bool next(int i, Unit& u) const {
        const long L = (long)i * G + c; if (L >= nwg) return false;
        int wgid = (int)L; { const int q = nwg / NXCD, r = nwg % NXCD, xcd = wgid % NXCD, off = wgid / NXCD; wgid = (xcd < r ? xcd * (q + 1) : r * (q + 1) + (xcd - r) * q) + off; }
        const int nig = WGM * nN, gid = wgid / nig, fm = gid * WGM, gsz = (nM - fm) < WGM ? (nM - fm) : WGM;
        u.pm = fm + ((wgid % nig) % gsz); u.pn = (wgid % nig) / gsz; return true;
    }
    __device__ __forceinline__ void a_ready(const Unit&) const {}
    __device__ __forceinline__ void done(const Unit&) const {}
    __device__ __forceinline__ size_t a_off(const Unit& u, size_t tstep) const { return (size_t)u.pm * tstep; }
    __device__ __forceinline__ size_t b_off(const Unit& u, size_t tstep) const { return (size_t)u.pn * tstep; }
};
struct SplitOrder {
    int pm0, nM, nN, nS, kpart, G, c;
    __device__ __forceinline__ bool next(int i, Unit& u) const { const int tot = nM * nN * nS; int L = i * G + c; if (L >= tot) return false;
        if ((G & 7) == 0 && (i + 1) * G <= tot) L = i * G + (c & 7) * (G >> 3) + (c >> 3);
        const int ks = L / (nM * nN), rem = L % (nM * nN); u.pm = rem / nN; u.pn = ks * nN + rem % nN; return true; }
    __device__ __forceinline__ void a_ready(const Unit&) const {}
    __device__ __forceinline__ void done(const Unit&) const {}
    __device__ __forceinline__ size_t a_off(const Unit& u, size_t tstep) const { return (size_t)(pm0 + u.pm) * tstep + (size_t)(u.pn / nN) * kpart * 2; }
    __device__ __forceinline__ size_t b_off(const Unit& u, size_t tstep) const { return (size_t)(u.pn % nN) * tstep + (size_t)(u.pn / nN) * kpart * 2; }
};
__device__ __forceinline__ unsigned cvt_pk_bf16(float lo, float hi) { unsigned r; asm volatile("v_cvt_pk_bf16_f32 %0, %1, %2" : "=v"(r) : "v"(lo), "v"(hi)); return r; }
template <class Epi, class Sched, bool ALIGN_EPI = false, bool SP2 = false>
__device__ __forceinline__ void gemm_phase(PG8_LAS unsigned char* lds, const Gemm g, const Sched& S, const Epi& E) {
    const int tid = threadIdx.x, wid = __builtin_amdgcn_readfirstlane(tid >> 6), lane = tid & 63, wr = wid >> 2, wc = wid & 3, fr = lane & 15, fq = lane >> 4;
    const int K = g.K, nt = K / BK;
    unsigned voffA[2], voffB[2];
#pragma unroll
    for (int i = 0; i < 2; ++i) { int R, C; stage_rc(tid * 16 + i * 8192, R, C); const int Rb = Epi::PERM ? ((R & ~31) + perm32(R & 31)) : R;
        voffA[i] = (unsigned)(R * g.ldk + C) * 2u; voffB[i] = (unsigned)(Rb * g.ldk + C) * 2u; }
    const size_t kstep = (size_t)(BK * 2);
    const size_t hstep = (size_t)HALF * g.ldk * 2;
    const size_t tstep = 2 * hstep;
    const unsigned ldsw = (unsigned)wid * 1024u;
    const int aoff = lds_byte(wr * 64 + fr, fq * 8), boff = lds_byte(wc * 32 + fr, fq * 8);
#define PG8_SA(b, h) (((b) * 2 + (h)) * HTB)
#define PG8_SB(b, h) ((4 + (b) * 2 + (h)) * HTB)
#define PG8_STAGE(bufoff, gbase, voff) do { _Pragma("unroll") for (int _i = 0; _i < 2; ++_i) \
        __builtin_amdgcn_global_load_lds((const unsigned*)((const char*)(gbase) + (voff)[_i]), (PG8_LAS unsigned*)(lds + (bufoff) + ldsw + _i * 8192), 16, 0, 0); } while (0)
#define PG8_LDA(dst, b, h) do { _Pragma("unroll") for (int m = 0; m < 4; ++m) _Pragma("unroll") for (int k = 0; k < 2; ++k) dst[m][k] = *(const PG8_LAS bf16x8*)(lds + PG8_SA(b, h) + aoff + m * 2048 + k * 1024); } while (0)
#define PG8_LDB(dst, b, h) do { _Pragma("unroll") for (int n = 0; n < 2; ++n) _Pragma("unroll") for (int k = 0; k < 2; ++k) dst[n][k] = *(const PG8_LAS bf16x8*)(lds + PG8_SB(b, h) + boff + n * 2048 + k * 1024); } while (0)
#define PG8_MMA(ai, bj, At, Bt) do { __builtin_amdgcn_s_setprio(1); _Pragma("unroll") for (int m = 0; m < 4; ++m) _Pragma("unroll") for (int n = 0; n < 2; ++n) _Pragma("unroll") for (int k = 0; k < 2; ++k) \
        acc[ai][bj][m][n] = __builtin_amdgcn_mfma_f32_16x16x32_bf16(Bt[n][k], At[m][k], acc[ai][bj][m][n], 0, 0, 0); __builtin_amdgcn_s_setprio(0); } while (0)
#define PG8_WAIT_V(n) asm volatile("s_waitcnt vmcnt(" #n ")" ::: "memory")
#define PG8_WAIT_L(n) asm volatile("s_waitcnt lgkmcnt(" #n ")" ::: "memory")
#define PG8_BAR __builtin_amdgcn_s_barrier()
#define PG8_SCHED __builtin_amdgcn_sched_barrier(0)
    Unit cur, nxt; int ui = 0;
    if (!S.next(0, cur)) return;
    f32x4 acc[2][2][4][2];
#pragma unroll
    for (int a = 0; a < 2; ++a)
#pragma unroll
        for (int b = 0; b < 2; ++b)
#pragma unroll
            for (int m = 0; m < 4; ++m)
#pragma unroll
                for (int n = 0; n < 2; ++n) acc[a][b][m][n] = (f32x4){0.f, 0.f, 0.f, 0.f};
    bf16x8 At[4][2], B0[2][2], B1[2][2];
    const char* cA = (const char*)g.A + S.a_off(cur, tstep); const char* cB = (const char*)g.Bt + S.b_off(cur, tstep);
    S.a_ready(cur);
    if constexpr (SP2) {
        PG8_STAGE(PG8_SB(0, 0), cB, voffB); PG8_STAGE(PG8_SB(0, 1), cB + hstep, voffB); PG8_STAGE(PG8_SA(0, 0), cA, voffA); PG8_STAGE(PG8_SA(0, 1), cA + hstep, voffA);
        if (wr == 1) PG8_BAR;
        PG8_WAIT_V(2); PG8_BAR;
        PG8_STAGE(PG8_SB(1, 0), cB + kstep, voffB); PG8_STAGE(PG8_SA(1, 0), cA + kstep, voffA); PG8_STAGE(PG8_SB(1, 1), cB + hstep + kstep, voffB);
        PG8_WAIT_V(6); PG8_BAR;
    } else {
        PG8_STAGE(PG8_SB(0, 0), cB, voffB); PG8_STAGE(PG8_SA(0, 0), cA, voffA); PG8_STAGE(PG8_SB(0, 1), cB + hstep, voffB); PG8_STAGE(PG8_SA(0, 1), cA + hstep, voffA);
        if (wr == 1) PG8_BAR;
        PG8_WAIT_V(4); PG8_BAR;
        PG8_STAGE(PG8_SB(1, 0), cB + kstep, voffB); PG8_STAGE(PG8_SA(1, 0), cA + kstep, voffA); PG8_STAGE(PG8_SB(1, 1), cB + hstep + kstep, voffB);
        PG8_WAIT_V(6); PG8_BAR;
    }
    for (;;) {
        const bool has_next = S.next(ui + 1, nxt);
        const char* nA = has_next ? (const char*)g.A + S.a_off(nxt, tstep) : cA; const char* nB = has_next ? (const char*)g.Bt + S.b_off(nxt, tstep) : cB;
        for (int t = 0; t < nt; t += 2) {
            const bool last = (t == nt - 2);
            const char* a1 = cA + (size_t)(t + 1) * kstep;
            const char* a2 = last ? nA : cA + (size_t)(t + 2) * kstep; const char* b2 = last ? nB : cB + (size_t)(t + 2) * kstep;
            const char* a3 = a2 + kstep; const char* b3 = b2 + kstep;
            if (last && has_next) S.a_ready(nxt);
            if constexpr (SP2) {
            PG8_LDB(B0, 0, 0); PG8_LDB(B1, 0, 1); PG8_SCHED; PG8_LDA(At, 0, 0); PG8_STAGE(PG8_SA(1, 1), a1 + hstep, voffA);
            PG8_WAIT_V(8); PG8_WAIT_L(0); PG8_BAR; PG8_MMA(0, 0, At, B0); PG8_MMA(0, 1, At, B1); PG8_BAR; PG8_SCHED;
            PG8_LDA(At, 0, 1); PG8_STAGE(PG8_SB(0, 0), b2, voffB); PG8_STAGE(PG8_SB(0, 1), b2 + hstep, voffB); PG8_STAGE(PG8_SA(0, 0), a2, voffA);
            PG8_WAIT_V(8); PG8_WAIT_L(0); PG8_BAR; PG8_MMA(1, 0, At, B0); PG8_MMA(1, 1, At, B1); PG8_BAR; PG8_SCHED;
            PG8_LDB(B0, 1, 0); PG8_LDB(B1, 1, 1); PG8_SCHED; PG8_LDA(At, 1, 0); PG8_STAGE(PG8_SA(0, 1), a2 + hstep, voffA);
            PG8_WAIT_V(8); PG8_WAIT_L(0); PG8_BAR; PG8_MMA(0, 0, At, B0); PG8_MMA(0, 1, At, B1); PG8_BAR; PG8_SCHED;
            PG8_LDA(At, 1, 1); PG8_STAGE(PG8_SB(1, 0), b3, voffB); PG8_STAGE(PG8_SB(1, 1), b3 + hstep, voffB); PG8_STAGE(PG8_SA(1, 0), a3, voffA);
            PG8_WAIT_V(8); PG8_WAIT_L(0); PG8_BAR; PG8_MMA(1, 0, At, B0); PG8_MMA(1, 1, At, B1); PG8_BAR; PG8_SCHED;
            } else {
            PG8_LDB(B0, 0, 0); PG8_SCHED; PG8_LDA(At, 0, 0); PG8_STAGE(PG8_SA(1, 1), a1 + hstep, voffA);
            PG8_WAIT_L(8); PG8_BAR; PG8_WAIT_L(0); PG8_MMA(0, 0, At, B0); PG8_BAR; PG8_SCHED;
            PG8_LDB(B1, 0, 1); PG8_STAGE(PG8_SB(0, 0), b2, voffB);
            PG8_BAR; PG8_WAIT_L(0); PG8_MMA(0, 1, At, B1); PG8_BAR;
            PG8_LDA(At, 0, 1); PG8_STAGE(PG8_SA(0, 0), a2, voffA);
            PG8_BAR; PG8_WAIT_L(0); PG8_MMA(1, 0, At, B0); PG8_BAR; PG8_SCHED;
            PG8_STAGE(PG8_SB(0, 1), b2 + hstep, voffB);
            PG8_WAIT_V(6); PG8_BAR; PG8_MMA(1, 1, At, B1); PG8_BAR;
            PG8_LDB(B0, 1, 0); PG8_SCHED; PG8_LDA(At, 1, 0); PG8_STAGE(PG8_SA(0, 1), a2 + hstep, voffA);
            PG8_WAIT_L(8); PG8_BAR; PG8_WAIT_L(0); PG8_MMA(0, 0, At, B0); PG8_BAR; PG8_SCHED;
            PG8_LDB(B1, 1, 1); PG8_STAGE(PG8_SB(1, 0), b3, voffB);
            PG8_BAR; PG8_WAIT_L(0); PG8_MMA(0, 1, At, B1); PG8_BAR;
            PG8_LDA(At, 1, 1); PG8_STAGE(PG8_SA(1, 0), a3, voffA);
            PG8_BAR; PG8_WAIT_L(0); PG8_MMA(1, 0, At, B0); PG8_BAR; PG8_SCHED;
            PG8_STAGE(PG8_SB(1, 1), b3 + hstep, voffB);
            PG8_WAIT_V(6); PG8_BAR; PG8_MMA(1, 1, At, B1); PG8_BAR;
            }
        }
        if constexpr (ALIGN_EPI) { if (wr == 0) PG8_BAR; }
        if constexpr (!Epi::AFTER_DRAIN) { E(acc, cur, wr, wc, fr, fq); S.done(cur); }
        if (!has_next) break;
#pragma unroll
        for (int a = 0; a < 2; ++a)
#pragma unroll
            for (int b = 0; b < 2; ++b)
#pragma unroll
                for (int m = 0; m < 4; ++m)
#pragma unroll
                    for (int n = 0; n < 2; ++n) acc[a][b][m][n] = (f32x4){0.f, 0.f, 0.f, 0.f};
        cur = nxt; cA = nA; cB = nB; ++ui;
        if constexpr (ALIGN_EPI) { if (wr == 1) PG8_BAR; }
    }
    PG8_WAIT_V(0);
    if constexpr (!ALIGN_EPI) { if (wr == 0) PG8_BAR; }
    PG8_BAR;
    if constexpr (Epi::AFTER_DRAIN) { E.fused(acc, cur, wr, wc, fr, fq, lds, wid, lane); S.done(cur); }
#undef PG8_SA
#undef PG8_SB
#undef PG8_STAGE
#undef PG8_LDA
#undef PG8_LDB
#undef PG8_MMA
#undef PG8_WAIT_V
#undef PG8_WAIT_L
#undef PG8_BAR
#undef PG8_SCHED
}
}

#define DI __device__ __forceinline__
#define LAS __attribute__((address_space(3)))
typedef unsigned short bf16;
typedef short bf16x8 __attribute__((ext_vector_type(8)));
typedef float f32x4 __attribute__((ext_vector_type(4)));
typedef float f32x16 __attribute__((ext_vector_type(16)));
typedef unsigned u32x4 __attribute__((ext_vector_type(4)));
typedef unsigned u32x2 __attribute__((ext_vector_type(2)));
typedef __bf16 bf16x2_t __attribute__((ext_vector_type(2)));
typedef float f32x2_t __attribute__((ext_vector_type(2)));

constexpr int DM = 1024, NBP = 8, LP = 2048, NBS = 16, LS = 32, PAST = 2048;
constexpr int MP = NBP * LP, MS = NBS * LS, MT = MP + MS;
constexpr int NPROJ = 2816, DIN = 2824, DFF = 2816, NUP = 5632;
constexpr int CONVD = 768, NH = 8;
constexpr float EPS = 1e-6f;
constexpr int NCH = LP / 64;

constexpr size_t O_YP = 0, O_YS = 16777216, O_KP = 17301504, O_VP = 25690112, O_HP = 34078720, O_CSP = 34340864, O_CFP = 34359296,
                 O_KS = 34404352, O_VS = 34666496, O_HS = 34928640, O_CSS = 35452928, O_CFS = 35489792, O_END = 35579904;

constexpr size_t MiB = 1u << 20;
constexpr size_t WS_WIN = 1 * MiB, WS_WOUT = 7 * MiB, WS_WUP = 9 * MiB, WS_WDN = 20 * MiB;
constexpr size_t WS_A16 = 26 * MiB;
constexpr size_t WS_G = 60 * MiB, WS_U = 151 * MiB;
constexpr size_t WS_Q = 60 * MiB, WS_K = 77 * MiB, WS_V = 94 * MiB, WS_Z = 111 * MiB;
constexpr size_t WS_XBC = 128 * MiB;
constexpr size_t WS_ST = 153 * MiB;
constexpr size_t WS_DEC = 185 * MiB;
constexpr size_t WS_DT = 186 * MiB;
constexpr size_t WS_M = 188 * MiB;
constexpr size_t WS_F = 60 * MiB;
constexpr size_t WS_TR = 188 * MiB, WS_NAT = 210 * MiB;
constexpr size_t WS_MS = 153 * MiB;
constexpr size_t WS_FS = 126 * MiB;
constexpr int KS_OUT = 4, KS_DN = 11;
constexpr size_t WS_GH = 100 * MiB, WS_GF = 102 * MiB, WS_UF = 104 * MiB;
constexpr size_t WS_NEED = 254 * MiB;

constexpr int LDS_BYTES = 147456;

struct Params { const float* in[24]; float* out; unsigned char* ws; int ph_lo, ph_hi; };
#define PARAMS_T const __attribute__((address_space(4))) Params&
#define NOINL __device__ __forceinline__

DI unsigned pk2(float lo, float hi) { f32x2_t v = {lo, hi}; bf16x2_t b = __builtin_convertvector(v, bf16x2_t); return __builtin_bit_cast(unsigned, b); }
DI float bf2f(unsigned short u) { return __builtin_bit_cast(float, (unsigned)u << 16); }
DI float bflo(unsigned u) { return __builtin_bit_cast(float, u << 16); }
DI float bfhi(unsigned u) { return __builtin_bit_cast(float, u & 0xffff0000u); }
#define DPP_ADD(v, ctrl) ((v) + __builtin_bit_cast(float, __builtin_amdgcn_update_dpp(0, __builtin_bit_cast(int, (v)), (ctrl), 0xf, 0xf, true)))
DI float row_sum16(float v) {
    v = DPP_ADD(v, 0xB1); v = DPP_ADD(v, 0x4E); v = DPP_ADD(v, 0x141); v = DPP_ADD(v, 0x140); return v;
}
DI float rdlane(float v, int l) { return __builtin_bit_cast(float, __builtin_amdgcn_readlane(__builtin_bit_cast(int, v), l)); }
DI float wave_sum(float v) {
    v = row_sum16(v);
    return (rdlane(v, 0) + rdlane(v, 16)) + (rdlane(v, 32) + rdlane(v, 48));
}
DI float half_sum(float v) {
    v = row_sum16(v);
    const float a = rdlane(v, 0) + rdlane(v, 16), b = rdlane(v, 32) + rdlane(v, 48);
    return (threadIdx.x & 32) ? b : a;
}
DI float fexp2(float x) { return __builtin_amdgcn_exp2f(x); }
DI float flog2(float x) { return __builtin_amdgcn_logf(x); }
DI float frcp(float x) { return __builtin_amdgcn_rcpf(x); }
DI float silu_f(float v) { return v * frcp(1.f + fexp2(-1.4426950408889634f * v)); }
DI float gelu_tanh_f(float v) { const float u = v * (1.f + 0.044715f * v * v); return v * frcp(1.f + fexp2(-2.302208198f * u)); }
#define MFMA32(a, b, c) __builtin_amdgcn_mfma_f32_32x32x16_bf16((a), (b), (c), 0, 0, 0)
DI int crow(int i, int hh) { return (i & 3) + 8 * (i >> 2) + 4 * hh; }
DI int pi32(int m) { return (m & 0x13) | ((m & 8) >> 1) | ((m & 4) << 1); }
DI bf16x8 ld8_bf(const bf16* p) { return *(const bf16x8*)p; }
DI bf16x8 ld8_f32(const float* p) { const f32x4 a = *(const f32x4*)p, b = *(const f32x4*)(p + 4); u32x4 r = {pk2(a.x, a.y), pk2(a.z, a.w), pk2(b.x, b.y), pk2(b.z, b.w)}; return __builtin_bit_cast(bf16x8, r); }
DI bf16x8 pack8(float a0, float a1, float a2, float a3, float a4, float a5, float a6, float a7) { u32x4 r = {pk2(a0, a1), pk2(a2, a3), pk2(a4, a5), pk2(a6, a7)}; return __builtin_bit_cast(bf16x8, r); }
DI f32x16 zero16() { f32x16 z;
#pragma unroll
    for (int i = 0; i < 16; ++i) z[i] = 0.f; return z; }

#define XB_TMO      128
#define XB_XCNT(j)  (256  + 64 * (j))
#define XB_XSUB(j)  (1280 + 64 * (j))
#define XB_XGEN(j)  (2304 + 64 * (j))
#define XB_TOP      3328
#define XB_TOPGEN   3392
#define XCD_BAR_WORDS 3456
#define XB_SPIN_CAP (1u << 18)

__device__ __forceinline__ unsigned xb_ld(unsigned* p)              { return __hip_atomic_load(p, __ATOMIC_RELAXED, __HIP_MEMORY_SCOPE_AGENT); }
__device__ __forceinline__ unsigned xb_add(unsigned* p, unsigned v) { return __hip_atomic_fetch_add(p, v, __ATOMIC_RELAXED, __HIP_MEMORY_SCOPE_AGENT); }
__device__ __forceinline__ unsigned xb_xcc_id() { return (unsigned)__builtin_amdgcn_s_getreg((3 << 11) | 20) & 0xFu; }
#define XB_SPIN(cond, bar) do { unsigned _sp = 0; while (cond) { __builtin_amdgcn_s_sleep(1); \
    if ((++_sp & 255u) == 0u) { if (xb_ld(&(bar)[XB_TMO])) break; if (_sp > XB_SPIN_CAP) { atomicAdd(&(bar)[XB_TMO], 1u); break; } } } } while (0)

struct XcdBarrier {
    unsigned* bar; unsigned x;
    volatile __attribute__((address_space(3))) unsigned* st;
};

__device__ __forceinline__ XcdBarrier xcd_barrier_post(unsigned* bar, volatile __attribute__((address_space(3))) unsigned* st) {
    XcdBarrier b; b.bar = bar; b.x = xb_xcc_id(); b.st = st;
    if (threadIdx.x == 0) (void)xb_add(&bar[XB_XCNT(b.x)], 1u);
    return b;
}
__device__ __forceinline__ void xcd_barrier_complete(unsigned* bar, unsigned x, unsigned& nloc, unsigned& nx) {
    const unsigned G = gridDim.x * gridDim.y * gridDim.z;
    unsigned sum, cnt, mine, sp = 0u;
    for (;;) {
        sum = 0u; cnt = 0u; mine = 0u;
#pragma unroll
        for (unsigned j = 0; j < 16; ++j) { const unsigned c = xb_ld(&bar[XB_XCNT(j)]); sum += c; cnt += (c > 0u) ? 1u : 0u; mine = (j == x) ? c : mine; }
        if (sum == G) break;
        __builtin_amdgcn_s_sleep(1);
        if ((++sp & 255u) == 0u) { if (xb_ld(&bar[XB_TMO])) break; if (sp > XB_SPIN_CAP) { atomicAdd(&bar[XB_TMO], 1u); break; } }
    }
    nloc = mine > 0u ? mine : 1u; nx = cnt > 0u ? cnt : 1u;
}

__device__ __forceinline__ void xcd_barrier(const XcdBarrier& b) {
    asm volatile("s_waitcnt vmcnt(0)" ::: "memory");
    __syncthreads();
    if (threadIdx.x == 0) {
        unsigned* bar = b.bar;
        __builtin_amdgcn_s_waitcnt(0);
        unsigned nloc = b.st[0], nx = b.st[1];
        if (nloc == 0u) { xcd_barrier_complete(bar, b.x, nloc, nx); b.st[0] = nloc; b.st[1] = nx; }
        const unsigned old = xb_add(&bar[XB_XSUB(b.x)], 1u);
        const unsigned gen = old / nloc;
        if (old + 1u == (gen + 1u) * nloc) {
            __builtin_amdgcn_fence(__ATOMIC_RELEASE, "agent");
            asm volatile("s_waitcnt vmcnt(0)" ::: "memory");
            const unsigned og = xb_add(&bar[XB_TOP], 1u);
            const unsigned tg = og / nx;
            if (og + 1u == (tg + 1u) * nx) xb_add(&bar[XB_TOPGEN], 1u);
            else XB_SPIN(xb_ld(&bar[XB_TOPGEN]) == tg, bar);
            __builtin_amdgcn_fence(__ATOMIC_ACQUIRE, "agent");
            xb_add(&bar[XB_XGEN(b.x)], 1u);
            asm volatile("s_waitcnt vmcnt(0)" ::: "memory");
        } else {
            XB_SPIN(xb_ld(&bar[XB_XGEN(b.x)]) == gen, bar);
            __builtin_amdgcn_fence(__ATOMIC_ACQUIRE, "agent");
            asm volatile("s_waitcnt vmcnt(0)" ::: "memory");
        }
    }
    __syncthreads();
}

struct EpiF32 {
    static constexpr bool PERM = true, AFTER_DRAIN = false;
    float* O; int ldc;
    DI void operator()(const pg8::f32x4 (&acc)[2][2][4][2], const pg8::Unit& u, int wr, int wc, int fr, int fq) const {
        const int row0 = u.pm * 256 + wr * 64 + fr, col0 = u.pn * 256 + wc * 32 + 8 * fq;
#pragma unroll
        for (int ai = 0; ai < 2; ++ai)
#pragma unroll
            for (int m = 0; m < 4; ++m) { float* rp = O + (size_t)(row0 + ai * 128 + m * 16) * ldc + col0;
#pragma unroll
                for (int bj = 0; bj < 2; ++bj) { *(f32x4*)(rp + bj * 128) = acc[ai][bj][m][0]; *(f32x4*)(rp + bj * 128 + 4) = acc[ai][bj][m][1]; } }
    }
};
struct EpiF32Split {
    static constexpr bool PERM = true, AFTER_DRAIN = false;
    float* O; bf16* ob;
    DI void operator()(const pg8::f32x4 (&acc)[2][2][4][2], const pg8::Unit& u, int wr, int wc, int fr, int fq) const {
        const int ks = u.pn >> 2, pn = u.pn & 3; const int row0 = u.pm * 256 + wr * 64 + fr, col0 = pn * 256 + wc * 32 + 8 * fq;
        if (ob) {
#pragma unroll
            for (int ai = 0; ai < 2; ++ai)
#pragma unroll
                for (int m = 0; m < 4; ++m) { bf16* rp = ob + (size_t)(row0 + ai * 128 + m * 16) * DM + col0;
#pragma unroll
                    for (int bj = 0; bj < 2; ++bj) { const pg8::f32x4 v0 = acc[ai][bj][m][0], v1 = acc[ai][bj][m][1];
                        u32x4 w = {pk2(v0[0], v0[1]), pk2(v0[2], v0[3]), pk2(v1[0], v1[1]), pk2(v1[2], v1[3])}; *(u32x4*)(rp + bj * 128) = w; } }
        } else {
            float* base = O + (size_t)ks * MS * DM;
#pragma unroll
            for (int ai = 0; ai < 2; ++ai)
#pragma unroll
                for (int m = 0; m < 4; ++m) { float* rp = base + (size_t)(row0 + ai * 128 + m * 16) * DM + col0;
#pragma unroll
                    for (int bj = 0; bj < 2; ++bj) { *(f32x4*)(rp + bj * 128) = acc[ai][bj][m][0]; *(f32x4*)(rp + bj * 128 + 4) = acc[ai][bj][m][1]; } }
        }
    }
};
struct EpiInProj {
    static constexpr bool PERM = true, AFTER_DRAIN = false;
    unsigned char* ws; float* out;
    DI void operator()(const pg8::f32x4 (&acc)[2][2][4][2], const pg8::Unit& u, int wr, int wc, int fr, int fq) const {
        const int row0 = u.pm * 256 + wr * 64 + fr; const int pn = u.pn;
        bf16* dst; int ldd, colb; float* fo_p = nullptr; float* fo_s = nullptr;
        if (pn < 8) { const int t = pn >> 1; dst = (bf16*)(ws + WS_Q + (size_t)t * (WS_K - WS_Q)); ldd = 512; colb = (pn & 1) * 256 + wc * 32 + 8 * fq;
            if (t == 1) { fo_p = out + O_KP; fo_s = out + O_KS; } else if (t == 2) { fo_p = out + O_VP; fo_s = out + O_VS; } }
        else { dst = (bf16*)(ws + WS_XBC); ldd = CONVD; colb = (pn - 8) * 256 + wc * 32 + 8 * fq; }
#pragma unroll
        for (int ai = 0; ai < 2; ++ai)
#pragma unroll
            for (int m = 0; m < 4; ++m) { const int row = row0 + ai * 128 + m * 16;
#pragma unroll
                for (int bj = 0; bj < 2; ++bj) { const pg8::f32x4 v0 = acc[ai][bj][m][0], v1 = acc[ai][bj][m][1]; const int col = colb + bj * 128;
                    u32x4 w = {pk2(v0[0], v0[1]), pk2(v0[2], v0[3]), pk2(v1[0], v1[1]), pk2(v1[2], v1[3])};
                    *(u32x4*)(dst + (size_t)row * ldd + col) = w;
                    if (fo_p) { float* fp = (row < MP) ? fo_p + (size_t)row * 512 + col : fo_s + (size_t)(row - MP) * 512 + col; *(f32x4*)fp = v0; *(f32x4*)(fp + 4) = v1; }
                    if (pn >= 8) {
                        float* fp = nullptr;
                        if (row < MP) { const int t = row & (LP - 1); if (t >= LP - 3) fp = out + O_CSP + ((size_t)(row >> 11) * 3 + (t - (LP - 3))) * CONVD + col; }
                        else { const int rr = row - MP, t = rr & (LS - 1); if (t >= LS - 3) fp = out + O_CSS + ((size_t)(rr >> 5) * 3 + (t - (LS - 3))) * CONVD + col; }
                        if (fp) { *(f32x4*)fp = v0; *(f32x4*)(fp + 4) = v1; } } } }
    }
};
#define DPP_ROR(v, n) __builtin_bit_cast(float, __builtin_amdgcn_update_dpp(0, __builtin_bit_cast(int, (v)), 0x120 + (n), 0xf, 0xf, false))
struct EpiUpAct {
    static constexpr bool PERM = true, AFTER_DRAIN = false;
    bf16* ACT; float* out; float* GH; float* GF; float* UF; const float* cw; const float* cb; const float* sffn; LAS float* hb;
    DI void operator()(const pg8::f32x4 (&acc)[2][2][4][2], const pg8::Unit& u, int wr, int wc, int fr, int fq) const {
        const int pm = u.pm, colb = u.pn * 128 + wc * 32 + 8 * fq; const bool sample = pm >= MP / 256;
        const bool need_prev = !sample && (pm & 7) != 0;
        const int lcol = wc * 32 + 8 * fq;
        if (fr >= 14) {
#pragma unroll
            for (int ai = 0; ai < 2; ++ai) { LAS float* d = hb + ((2 * ai + wr) * 2 + (fr - 14)) * 128 + lcol; *(LAS f32x4*)d = acc[ai][0][3][0]; *(LAS f32x4*)(d + 4) = acc[ai][0][3][1]; } }
        asm volatile("s_waitcnt lgkmcnt(0)" ::: "memory"); __builtin_amdgcn_s_barrier(); asm volatile("" ::: "memory");
        f32x4 w0[2], w1[2], w2[2], bs[2];
#pragma unroll
        for (int n = 0; n < 2; ++n) { w0[n] = *(const f32x4*)(cw + colb + 4 * n); w1[n] = *(const f32x4*)(cw + DFF + colb + 4 * n); w2[n] = *(const f32x4*)(cw + 2 * DFF + colb + 4 * n); bs[n] = *(const f32x4*)(cb + colb + 4 * n); }
#pragma unroll
        for (int ai = 0; ai < 2; ++ai) {
            const int slab = 2 * ai + wr;
            f32x4 hprev[2];
#pragma unroll
            for (int n = 0; n < 2; ++n) { hprev[n] = (f32x4){0.f, 0.f, 0.f, 0.f};
                if (slab > 0 && fr >= 14) hprev[n] = *(const LAS f32x4*)(hb + ((slab - 1) * 2 + (fr - 14)) * 128 + lcol + 4 * n); }
#pragma unroll
            for (int m = 0; m < 4; ++m) {
                const int row = pm * 256 + ai * 128 + wr * 64 + m * 16 + fr;
                f32x4 gp[2];
#pragma unroll
                for (int n = 0; n < 2; ++n) gp[n] = (m == 0) ? hprev[n] : acc[ai][0][m - 1][n];
                if (sample && (m == 0 || m == 2)) {
                    const int bsq = (pm * 256 + ai * 128 + wr * 64 + m * 16 - MP) >> 5;
#pragma unroll
                    for (int n = 0; n < 2; ++n) { gp[n] = (f32x4){0.f, 0.f, 0.f, 0.f}; if (fr >= 14) gp[n] = *(const f32x4*)(sffn + ((size_t)bsq * 2 + (fr - 14)) * DFF + colb + 4 * n); }
                }
                u32x4 w;
#pragma unroll
                for (int n = 0; n < 2; ++n) { float a[4];
#pragma unroll
                    for (int j = 0; j < 4; ++j) { const float g = acc[ai][0][m][n][j], gq = gp[n][j];
                        const float p1 = DPP_ROR(fr == 15 ? gq : g, 1), p2 = DPP_ROR(fr >= 14 ? gq : g, 2);
                        a[j] = gelu_tanh_f(bs[n][j] + w0[n][j] * p2 + w1[n][j] * p1 + w2[n][j] * g) * acc[ai][1][m][n][j]; }
                    if (n == 0) { w.x = pk2(a[0], a[1]); w.y = pk2(a[2], a[3]); } else { w.z = pk2(a[0], a[1]); w.w = pk2(a[2], a[3]); } }
                *(u32x4*)(ACT + (size_t)row * DFF + colb) = w;
                { float* fp = nullptr;
                  if (row < MP) { const int t = row & (LP - 1); if (t >= LP - 2) fp = out + O_CFP + ((size_t)(row >> 11) * 2 + (t - (LP - 2))) * DFF + colb; }
                  else { const int rr = row - MP, t = rr & (LS - 1); if (t >= LS - 2) fp = out + O_CFS + ((size_t)(rr >> 5) * 2 + (t - (LS - 2))) * DFF + colb; }
                  if (fp) { *(f32x4*)fp = acc[ai][0][m][0]; *(f32x4*)(fp + 4) = acc[ai][0][m][1]; } }
                if (ai == 1 && m == 3 && wr == 1 && fr >= 14 && !sample) { float* gp2 = GH + ((size_t)pm * 2 + (fr - 14)) * DFF + colb; *(f32x4*)gp2 = acc[1][0][3][0]; *(f32x4*)(gp2 + 4) = acc[1][0][3][1]; }
                if (ai == 0 && m == 0 && wr == 0 && fr < 2 && need_prev) { float* g2 = GF + ((size_t)pm * 2 + fr) * DFF + colb; *(f32x4*)g2 = acc[0][0][0][0]; *(f32x4*)(g2 + 4) = acc[0][0][0][1];
                    float* u2 = UF + ((size_t)pm * 2 + fr) * DFF + colb; *(f32x4*)u2 = acc[0][1][0][0]; *(f32x4*)(u2 + 4) = acc[0][1][0][1]; }
            }
        }
        asm volatile("s_waitcnt lgkmcnt(0)" ::: "memory"); __builtin_amdgcn_s_barrier(); asm volatile("" ::: "memory");
    }
};
DI void ffn_fixup(PARAMS_T p, int pm) {
    if (pm >= MP / 256 || (pm & 7) == 0) return;
    const float* GH = (const float*)(p.ws + WS_GH) + (size_t)(pm - 1) * 2 * DFF; const float* GF = (const float*)(p.ws + WS_GF) + (size_t)pm * 2 * DFF; const float* UF = (const float*)(p.ws + WS_UF) + (size_t)pm * 2 * DFF;
    const float* cw = p.in[21]; const float* cb = p.in[22]; bf16* ACT = (bf16*)(p.ws + WS_U) + (size_t)pm * 256 * DFF;
    for (int c = threadIdx.x; c < DFF; c += 512) {
        const float h0 = GH[c], h1 = GH[DFF + c], g0 = GF[c], g1 = GF[DFF + c], w0 = cw[c], w1 = cw[DFF + c], w2 = cw[2 * DFF + c], b = cb[c];
        ACT[c] = (bf16)(pk2(gelu_tanh_f(b + w0 * h0 + w1 * h1 + w2 * g0) * UF[c], 0.f) & 0xffffu);
        ACT[DFF + c] = (bf16)(pk2(gelu_tanh_f(b + w0 * h1 + w1 * g0 + w2 * g1) * UF[DFF + c], 0.f) & 0xffffu);
    }
}

DI void p0_transpose_item(const float* W, int ldw, int K, bf16* WT, int dst_row0, int k0, int n0, LAS float* scr, int lane) {
    float wreg[32];
#pragma unroll
    for (int i = 0; i < 32; ++i) wreg[i] = W[(size_t)(k0 + 2 * i + (lane >> 5)) * ldw + n0 + (lane & 31)];
#pragma unroll
    for (int i = 0; i < 32; ++i) scr[(2 * i + (lane >> 5)) * 33 + (lane & 31)] = wreg[i];
    asm volatile("s_waitcnt lgkmcnt(0)" ::: "memory");
    const int c = lane & 7;
#pragma unroll
    for (int j = 0; j < 4; ++j) { const int n = (lane >> 3) + 8 * j; const LAS float* s = scr + (8 * c) * 33 + n;
        u32x4 o = {pk2(s[0 * 33], s[1 * 33]), pk2(s[2 * 33], s[3 * 33]), pk2(s[4 * 33], s[5 * 33]), pk2(s[6 * 33], s[7 * 33])};
        *(u32x4*)(WT + (size_t)(dst_row0 + n) * K + k0 + 8 * c) = o; }
    asm volatile("s_waitcnt lgkmcnt(0)" ::: "memory");
}
NOINL void phase_prologue(PARAMS_T p, LAS unsigned char* lds) {
    const int tid = threadIdx.x, lane = tid & 63, wave = __builtin_amdgcn_readfirstlane(tid >> 6);
    const int gw = blockIdx.x * 8 + wave, NGW = gridDim.x * 8;
    LAS float* scr = (LAS float*)(lds + wave * 8448);
    LAS float* wdt = (LAS float*)(lds + 8 * 8448);
    const float* w_in = p.in[9];
    for (int k = tid; k < DM; k += 512) { const f32x4 a = *(const f32x4*)(w_in + (size_t)k * DIN + NPROJ), b = *(const f32x4*)(w_in + (size_t)k * DIN + NPROJ + 4);
        wdt[0 * DM + k] = a.x; wdt[1 * DM + k] = a.y; wdt[2 * DM + k] = a.z; wdt[3 * DM + k] = a.w; wdt[4 * DM + k] = b.x; wdt[5 * DM + k] = b.y; wdt[6 * DM + k] = b.z; wdt[7 * DM + k] = b.w; }
    constexpr int I_IN = 16 * 88, I_OUT = 16 * 32, I_UP = 16 * 176, I_DN = 44 * 32, NITEMS = I_IN + I_OUT + I_UP + I_DN;
    for (int it = gw; it < NITEMS; it += NGW) {
        int r = it;
        if (r < I_IN) { const int kb = r / 88, nb = r % 88; p0_transpose_item(w_in, DIN, DM, (bf16*)(p.ws + WS_WIN), 32 * nb, 64 * kb, 32 * nb, scr, lane); continue; } r -= I_IN;
        if (r < I_OUT) { const int kb = r / 32, nb = r % 32; p0_transpose_item(p.in[17], DM, DM, (bf16*)(p.ws + WS_WOUT), 32 * nb, 64 * kb, 32 * nb, scr, lane); continue; } r -= I_OUT;
        if (r < I_UP) { const int kb = r / 176, nb = r % 176, n0 = 32 * nb, isup = n0 >= DFF, j = n0 - isup * DFF;
            p0_transpose_item(p.in[20], NUP, DM, (bf16*)(p.ws + WS_WUP), (j >> 7) * 256 + isup * 128 + (j & 127), 64 * kb, n0, scr, lane); continue; } r -= I_UP;
        { const int kb = r / 32, nb = r % 32; p0_transpose_item(p.in[23], DM, DFF, (bf16*)(p.ws + WS_WDN), 32 * nb, 64 * kb, 32 * nb, scr, lane); }
    }
    __syncthreads();
    const float* g = p.in[7];
    f32x4 gv[4];
#pragma unroll
    for (int j = 0; j < 4; ++j) gv[j] = *(const f32x4*)(g + 4 * lane + 256 * j);
    for (int row0 = gw; row0 < MT; row0 += 2 * NGW) {
        const int row1 = row0 + NGW; const bool has1 = row1 < MT; const int rowb = has1 ? row1 : row0;
        const float* xr0 = (row0 < MP) ? p.in[0] + (size_t)row0 * DM : p.in[1] + (size_t)(row0 - MP) * DM;
        const float* xr1 = (rowb < MP) ? p.in[0] + (size_t)rowb * DM : p.in[1] + (size_t)(rowb - MP) * DM;
        f32x4 v[2][4]; float s0 = 0.f, s1 = 0.f;
#pragma unroll
        for (int j = 0; j < 4; ++j) { v[0][j] = *(const f32x4*)(xr0 + 4 * lane + 256 * j); v[1][j] = *(const f32x4*)(xr1 + 4 * lane + 256 * j); }
#pragma unroll
        for (int j = 0; j < 4; ++j) { s0 += (v[0][j].x * v[0][j].x + v[0][j].y * v[0][j].y) + (v[0][j].z * v[0][j].z + v[0][j].w * v[0][j].w); s1 += (v[1][j].x * v[1][j].x + v[1][j].y * v[1][j].y) + (v[1][j].z * v[1][j].z + v[1][j].w * v[1][j].w); }
        const float rstd0 = __builtin_amdgcn_rsqf(wave_sum(s0) * (1.f / DM) + EPS), rstd1 = __builtin_amdgcn_rsqf(wave_sum(s1) * (1.f / DM) + EPS);
#pragma unroll
        for (int q = 0; q < 2; ++q) {
            if (q == 1 && !has1) break;
            const int row = q ? row1 : row0; const float rstd = q ? rstd1 : rstd0;
#pragma unroll
            for (int j = 0; j < 4; ++j) v[q][j] = v[q][j] * rstd * gv[j];
            bf16* orow = (bf16*)(p.ws + WS_A16) + (size_t)row * DM;
#pragma unroll
            for (int j = 0; j < 4; ++j) { u32x2 o = {pk2(v[q][j].x, v[q][j].y), pk2(v[q][j].z, v[q][j].w)}; *(u32x2*)(orow + 4 * lane + 256 * j) = o; }
            float d[8];
#pragma unroll
            for (int k = 0; k < 8; ++k) { float a = 0.f;
#pragma unroll
                for (int j = 0; j < 4; ++j) { const f32x4 w = *(const LAS f32x4*)(wdt + k * DM + 4 * lane + 256 * j); a += (v[q][j].x * w.x + v[q][j].y * w.y) + (v[q][j].z * w.z + v[q][j].w * w.w); }
                d[k] = wave_sum(a); }
            if (lane == 0) { float* dp = (float*)(p.ws + WS_DT) + (size_t)row * 8; *(f32x4*)dp = (f32x4){d[0], d[1], d[2], d[3]}; *(f32x4*)(dp + 4) = (f32x4){d[4], d[5], d[6], d[7]}; }
        }
    }
}

constexpr float ATT_C2 = 0.125f * 1.4426950408889634f;
constexpr float ATT_EXIT = 92.f;
constexpr int VS_PITCH = 68;

template <bool F32>
DI void attn_step(const void* Kp, const void* Vp, int nrows, int kbase, int q_abs, const bf16x8 (&qf)[4], f32x16 (&o)[2], float& R, LAS bf16* vs, int lane) {
    const int r = lane & 31, hh = lane >> 5;
    int krow = pi32(r); krow = krow < nrows ? krow : nrows - 1;
    bf16x8 kf[4];
#pragma unroll
    for (int s = 0; s < 4; ++s) { const size_t off = (size_t)krow * 512 + 16 * s + 8 * hh; kf[s] = F32 ? ld8_f32((const float*)Kp + off) : ld8_bf((const bf16*)Kp + off); }
#pragma unroll
    for (int i = 0; i < 4; ++i) { const int key = (lane & 7) + 8 * i, dch = lane >> 3; const int kr = key < nrows ? key : nrows - 1; const size_t off = (size_t)kr * 512 + dch * 8;
        const bf16x8 v = F32 ? ld8_f32((const float*)Vp + off) : ld8_bf((const bf16*)Vp + off); const u32x4 vu = __builtin_bit_cast(u32x4, v);
        LAS u32x2* d = (LAS u32x2*)(vs + key * VS_PITCH + dch * 8); d[0] = (u32x2){vu.x, vu.y}; d[1] = (u32x2){vu.z, vu.w}; }
    f32x16 st = zero16();
#pragma unroll
    for (int s = 0; s < 4; ++s) st = MFMA32(kf[s], qf[s], st);
    float z[16], c[16]; bool valid[16];
#pragma unroll
    for (int i = 0; i < 16; ++i) { const int key = kbase + 16 * (i >> 3) + 8 * hh + (i & 7); valid[i] = key < q_abs; z[i] = st[i] * ATT_C2;
        const float sp = fmaxf(z[i], 0.f) + flog2(1.f + fexp2(-fabsf(z[i]))); c[i] = valid[i] ? sp : 0.f; }
#pragma unroll
    for (int i = 6; i >= 0; --i) { c[i] += c[i + 1]; c[8 + i] += c[8 + i + 1]; }
    const float g0 = c[0], g1 = c[8], og0 = __shfl_xor(g0, 32), og1 = __shfl_xor(g1, 32);
    const float b1 = R + (hh ? 0.f : og1), b0 = R + (hh ? (og1 + g1) : (og0 + g1 + og1));
    float w[16];
#pragma unroll
    for (int i = 0; i < 16; ++i) { const float e = fexp2(z[i] - (c[i] + (i < 8 ? b0 : b1))); w[i] = valid[i] ? e : 0.f; }
    R += (g0 + g1) + (og0 + og1);
    const bf16x8 pf0 = pack8(w[0], w[1], w[2], w[3], w[4], w[5], w[6], w[7]), pf1 = pack8(w[8], w[9], w[10], w[11], w[12], w[13], w[14], w[15]);
#pragma unroll
    for (int s = 0; s < 2; ++s)
#pragma unroll
        for (int db = 0; db < 2; ++db) { const LAS bf16* vp = vs + (16 * s + 8 * hh) * VS_PITCH + r + 32 * db;
            bf16x8 vf;
#pragma unroll
            for (int j = 0; j < 8; ++j) vf[j] = (short)vp[j * VS_PITCH];
            o[db] = MFMA32(s ? pf1 : pf0, vf, o[db]); }
}

template <bool SAMPLE>
NOINL void attn_item(PARAMS_T p, int b, int qblk, LAS unsigned char* lds) {
    const int tid = threadIdx.x, lane = tid & 63, head = __builtin_amdgcn_readfirstlane(tid >> 6), r = lane & 31, hh = lane >> 5;
    LAS bf16* vs = (LAS bf16*)(lds + head * (32 * VS_PITCH * 2));
    LAS float* red = (LAS float*)(lds + 8 * (32 * VS_PITCH * 2));
    LAS float* rs = red + 256;
    const bf16* Qb = (const bf16*)(p.ws + WS_Q); const bf16* Kb = (const bf16*)(p.ws + WS_K); const bf16* Vb = (const bf16*)(p.ws + WS_V);
    const int tok0 = SAMPLE ? (MP + b * LS) : (b * LP + qblk * 32);
    bf16x8 qf[4];
#pragma unroll
    for (int s = 0; s < 4; ++s) qf[s] = ld8_bf(Qb + (size_t)(tok0 + r) * 512 + head * 64 + 16 * s + 8 * hh);
    f32x16 o[2]; o[0] = zero16(); o[1] = zero16();
    float R = 0.f;
    const int q_abs = SAMPLE ? (PAST + r) : (qblk * 32 + r);
    if (SAMPLE) {
        attn_step<false>(Kb + (size_t)tok0 * 512 + head * 64, Vb + (size_t)tok0 * 512 + head * 64, 32, PAST, q_abs, qf, o, R, vs, lane);
        const float* ck = p.in[2] + (size_t)b * PAST * 512 + head * 64; const float* cv = p.in[3] + (size_t)b * PAST * 512 + head * 64;
        for (int j = 1; j <= PAST / 32; ++j) {
            if (__ballot(R < ATT_EXIT) == 0ull) break;
            const int kbase = PAST - 32 * j;
            attn_step<true>(ck + (size_t)kbase * 512, cv + (size_t)kbase * 512, 32, kbase, q_abs, qf, o, R, vs, lane);
        }
    } else {
        for (int j = qblk; j >= 0; --j) {
            const size_t ro = (size_t)(b * LP + j * 32) * 512 + head * 64;
            attn_step<false>(Kb + ro, Vb + ro, 32, j * 32, q_abs, qf, o, R, vs, lane);
            if (__ballot(R < ATT_EXIT) == 0ull) break;
        }
    }
    float ss[16];
#pragma unroll
    for (int i = 0; i < 16; ++i) ss[i] = half_sum(o[0][i] * o[0][i] + o[1][i] * o[1][i]);
    if (r == 0) {
#pragma unroll
        for (int i = 0; i < 16; ++i) red[head * 32 + crow(i, hh)] = ss[i]; }
    __syncthreads();
    if (tid < 32) { float a = 0.f;
#pragma unroll
        for (int w = 0; w < 8; ++w) a += red[w * 32 + tid];
        rs[tid] = __builtin_amdgcn_rsqf(a * (1.f / 512.f) + EPS); }
    __syncthreads();
    const float* ga = p.in[16];
    const float g0 = ga[head * 64 + r], g1 = ga[head * 64 + 32 + r];
    bf16* mix = (bf16*)(p.ws + WS_A16);
#pragma unroll
    for (int i = 0; i < 16; ++i) { const int q = crow(i, hh); const float sc = rs[q]; bf16* mp = mix + (size_t)(tok0 + q) * DM + head * 64 + r;
        mp[0] = (bf16)(pk2(o[0][i] * sc * g0, 0.f) & 0xffffu); mp[32] = (bf16)(pk2(o[1][i] * sc * g1, 0.f) & 0xffffu); }
    __syncthreads();
}

constexpr int NCHUNK = NBP * NCH + NBS;
NOINL void conv_chunk(PARAMS_T p, int chunk) {
    const int lane = threadIdx.x & 63, wv = threadIdx.x >> 6;
    const bf16* XBC = (const bf16*)(p.ws + WS_XBC); bf16* TR = (bf16*)(p.ws + WS_TR); bf16* NAT = (bf16*)(p.ws + WS_NAT);
    const float* cw = p.in[10]; const float* cb = p.in[11];
    for (int task = wv; task < 48; task += 8) {
        const int cgp = task % 12, t16 = task / 12;
        const bool sample = chunk >= NBP * NCH; const int bs = chunk - NBP * NCH;
        const int tok0 = sample ? MP + LS * bs : chunk * 64, nvalid = sample ? LS : 64, tbase = t16 * 16, ch = cgp * 64 + lane;
        float y[16];
        if (tbase >= nvalid) {
#pragma unroll
            for (int j = 0; j < 16; ++j) y[j] = 0.f;
        } else {
            float xr[19];
            const bf16* xp = XBC + (size_t)(tok0 + tbase) * CONVD + ch;
#pragma unroll
            for (int k = 3; k < 19; ++k) xr[k] = bf2f(xp[(size_t)(k - 3) * CONVD]);
            if (tbase > 0 || (!sample && (chunk & (NCH - 1)) != 0)) {
#pragma unroll
                for (int k = 0; k < 3; ++k) xr[k] = bf2f(xp[(ptrdiff_t)(k - 3) * CONVD]);
            } else if (sample) {
#pragma unroll
                for (int k = 0; k < 3; ++k) xr[k] = p.in[5][((size_t)bs * 3 + k) * CONVD + ch];
            } else { xr[0] = 0.f; xr[1] = 0.f; xr[2] = 0.f; }
            const float w0 = cw[ch], w1 = cw[CONVD + ch], w2 = cw[2 * CONVD + ch], w3 = cw[3 * CONVD + ch], bi = cb[ch];
#pragma unroll
            for (int j = 0; j < 16; ++j) y[j] = silu_f(bi + w0 * xr[j] + w1 * xr[j + 1] + w2 * xr[j + 2] + w3 * xr[j + 3]);
        }
        if (ch < 640) { bf16* tp = TR + ((size_t)chunk * 640 + ch) * 64 + tbase;
            *(bf16x8*)tp = pack8(y[0], y[1], y[2], y[3], y[4], y[5], y[6], y[7]); *(bf16x8*)(tp + 8) = pack8(y[8], y[9], y[10], y[11], y[12], y[13], y[14], y[15]); }
        if (ch >= 512) { bf16* np = NAT + ((size_t)chunk * 64 + tbase) * 256 + (ch - 512);
#pragma unroll
            for (int j = 0; j < 16; ++j) np[j * 256] = (bf16)(pk2(y[j], 0.f) & 0xffffu); }
    }
}

constexpr int SSD_W = 0, SSD_RED = 8 * 768, SSD_RS = SSD_RED + 2048;
DI void unpack8s(const bf16x8 v, float (&f)[8]) { const u32x4 u = __builtin_bit_cast(u32x4, v); f[0] = bflo(u.x); f[1] = bfhi(u.x); f[2] = bflo(u.y); f[3] = bfhi(u.y); f[4] = bflo(u.z); f[5] = bfhi(u.z); f[6] = bflo(u.w); f[7] = bfhi(u.w); }
template <bool PH3>
NOINL void ssd_item(PARAMS_T p, int chunk, LAS unsigned char* lds) {
    const int tid = threadIdx.x, lane = tid & 63, h = __builtin_amdgcn_readfirstlane(tid >> 6), r = lane & 31, hh = lane >> 5, g = h >> 2;
    const bool sample = chunk >= NBP * NCH; const int bs = chunk - NBP * NCH;
    const int tok0 = sample ? MP + LS * bs : chunk * 64, nvalid = sample ? LS : 64;
    LAS float* dtw = (LAS float*)(lds + SSD_W + h * 768); LAS float* acw = dtw + 64; LAS float* exw = dtw + 128;
    LAS float* red = (LAS float*)(lds + SSD_RED); LAS float* rs = (LAS float*)(lds + SSD_RS);
    const bf16* TR = (const bf16*)(p.ws + WS_TR) + (size_t)chunk * 640 * 64; const bf16* NAT = (const bf16*)(p.ws + WS_NAT) + (size_t)chunk * 64 * 256;
    const float a_h = -expf(p.in[13][h]);
    float dt = 0.f;
    if (lane < nvalid) { const float x = ((const float*)(p.ws + WS_DT))[(size_t)(tok0 + lane) * 8 + h] + p.in[12][h]; dt = x > 20.f ? x : log1pf(expf(x)); }
    float ac = dt * a_h;
#pragma unroll
    for (int o = 1; o < 64; o <<= 1) { const float t = __shfl_up(ac, o); if (lane >= o) ac += t; }
    const float atot = __shfl(ac, 63);
    dtw[lane] = dt; acw[lane] = ac; exw[lane] = PH3 ? expf(ac) : expf(atot - ac) * dt;
    if (!PH3) {
        f32x16 st[2][2];
#pragma unroll
        for (int i = 0; i < 2; ++i)
#pragma unroll
            for (int j = 0; j < 2; ++j) st[i][j] = zero16();
#pragma unroll
        for (int ks = 0; ks < 4; ++ks) { bf16x8 a[2], bb[2]; float wv[8];
#pragma unroll
            for (int j = 0; j < 8; ++j) wv[j] = exw[16 * ks + 8 * hh + j];
#pragma unroll
            for (int i = 0; i < 2; ++i) { float xf[8]; unpack8s(ld8_bf(TR + (size_t)(h * 64 + r + 32 * i) * 64 + 16 * ks + 8 * hh), xf);
                a[i] = pack8(xf[0] * wv[0], xf[1] * wv[1], xf[2] * wv[2], xf[3] * wv[3], xf[4] * wv[4], xf[5] * wv[5], xf[6] * wv[6], xf[7] * wv[7]);
                bb[i] = ld8_bf(TR + (size_t)(512 + g * 64 + r + 32 * i) * 64 + 16 * ks + 8 * hh); }
#pragma unroll
            for (int i = 0; i < 2; ++i)
#pragma unroll
                for (int j = 0; j < 2; ++j) st[i][j] = MFMA32(a[i], bb[j], st[i][j]); }
        if (sample) {
            const float dec = expf(atot); const float* h0p = p.in[4] + (size_t)(bs * NH + h) * 4096; float* op = p.out + O_HS + (size_t)(bs * NH + h) * 4096;
#pragma unroll
            for (int pb = 0; pb < 2; ++pb)
#pragma unroll
                for (int nb = 0; nb < 2; ++nb)
#pragma unroll
                    for (int i = 0; i < 16; ++i) { const int idx = (crow(i, hh) + 32 * pb) * 64 + r + 32 * nb; op[idx] = dec * h0p[idx] + st[pb][nb][i]; }
        } else {
            float* sp = (float*)(p.ws + WS_ST) + (size_t)(chunk * NH + h) * 4096;
#pragma unroll
            for (int pb = 0; pb < 2; ++pb)
#pragma unroll
                for (int nb = 0; nb < 2; ++nb)
#pragma unroll
                    for (int i = 0; i < 16; ++i) sp[(crow(i, hh) + 32 * pb) * 64 + r + 32 * nb] = st[pb][nb][i];
            if (lane == 0) ((float*)(p.ws + WS_DEC))[chunk * NH + h] = expf(atot);
        }
    } else {
        const float* Hin = sample ? p.in[4] + (size_t)(bs * NH + h) * 4096 : (const float*)(p.ws + WS_ST) + (size_t)(chunk * NH + h) * 4096;
        f32x16 acc[2][2];
#pragma unroll
        for (int i = 0; i < 2; ++i)
#pragma unroll
            for (int j = 0; j < 2; ++j) acc[i][j] = zero16();
        bf16x8 cf[2][4];
#pragma unroll
        for (int tb = 0; tb < 2; ++tb)
#pragma unroll
            for (int ks = 0; ks < 4; ++ks) cf[tb][ks] = ld8_bf(NAT + (size_t)(r + 32 * tb) * 256 + 128 + g * 64 + 16 * ks + 8 * hh);
#pragma unroll
        for (int ks = 0; ks < 4; ++ks) { bf16x8 bb[2];
#pragma unroll
            for (int i = 0; i < 2; ++i) bb[i] = ld8_f32(Hin + (size_t)(r + 32 * i) * 64 + 16 * ks + 8 * hh);
#pragma unroll
            for (int i = 0; i < 2; ++i)
#pragma unroll
                for (int j = 0; j < 2; ++j) acc[i][j] = MFMA32(cf[i][ks], bb[j], acc[i][j]); }
#pragma unroll
        for (int tb = 0; tb < 2; ++tb)
#pragma unroll
            for (int i = 0; i < 16; ++i) { const float e = exw[crow(i, hh) + 32 * tb]; acc[tb][0][i] *= e; acc[tb][1][i] *= e; }
        const float Dh = p.in[14][h];
#pragma unroll
        for (int tb = 0; tb < 2; ++tb) {
            const int t = r + 32 * tb; const float at = acw[t];
#pragma unroll
            for (int sb = 0; sb <= tb; ++sb) {
                __builtin_amdgcn_sched_barrier(0);
                f32x16 cbt = zero16();
#pragma unroll
                for (int ks = 0; ks < 4; ++ks) { const bf16x8 a = ld8_bf(NAT + (size_t)(pi32(r) + 32 * sb) * 256 + g * 64 + 16 * ks + 8 * hh); cbt = MFMA32(a, cf[tb][ks], cbt); }
                float mv[16];
#pragma unroll
                for (int i = 0; i < 16; ++i) { const int s = 32 * sb + 16 * (i >> 3) + 8 * hh + (i & 7); const float e = expf(at - acw[s]) * dtw[s] * cbt[i]; mv[i] = (s <= t) ? e : 0.f; if (s == t) mv[i] += Dh; }
                const bf16x8 pf0 = pack8(mv[0], mv[1], mv[2], mv[3], mv[4], mv[5], mv[6], mv[7]), pf1 = pack8(mv[8], mv[9], mv[10], mv[11], mv[12], mv[13], mv[14], mv[15]);
#pragma unroll
                for (int ks2 = 0; ks2 < 2; ++ks2)
#pragma unroll
                    for (int pb = 0; pb < 2; ++pb) { const bf16x8 bb = ld8_bf(TR + (size_t)(h * 64 + r + 32 * pb) * 64 + 32 * sb + 16 * ks2 + 8 * hh); acc[tb][pb] = MFMA32(ks2 ? pf1 : pf0, bb, acc[tb][pb]); }
            }
        }
        const bf16* Zb = (const bf16*)(p.ws + WS_Z);
#pragma unroll
        for (int tb = 0; tb < 2; ++tb) {
            __builtin_amdgcn_sched_barrier(0);
            unsigned short zr[16][2];
#pragma unroll
            for (int i = 0; i < 16; ++i) { const int t = crow(i, hh) + 32 * tb; const bf16* zp = Zb + (size_t)(tok0 + (t < nvalid ? t : 0)) * 512 + h * 64 + r; zr[i][0] = zp[0]; zr[i][1] = zp[32]; }
#pragma unroll
            for (int i = 0; i < 16; ++i) { const int t = crow(i, hh) + 32 * tb;
                const float v0 = acc[tb][0][i] * silu_f(bf2f(zr[i][0])), v1 = acc[tb][1][i] * silu_f(bf2f(zr[i][1])); acc[tb][0][i] = v0; acc[tb][1][i] = v1;
                const float s2 = half_sum((t < nvalid) ? v0 * v0 + v1 * v1 : 0.f);
                if (r == 0) red[h * 64 + t] = s2; }
        }
        __builtin_amdgcn_sched_barrier(0);
        __syncthreads();
        if (tid < 64) { float a = 0.f;
#pragma unroll
            for (int w = 0; w < 8; ++w) a += red[w * 64 + tid];
            rs[tid] = __builtin_amdgcn_rsqf(a * (1.f / 512.f) + EPS); }
        __syncthreads();
        const float* gs = p.in[15]; const float g0 = gs[h * 64 + r], g1 = gs[h * 64 + 32 + r];
        bf16* mix = (bf16*)(p.ws + WS_A16);
#pragma unroll
        for (int tb = 0; tb < 2; ++tb)
#pragma unroll
            for (int i = 0; i < 16; ++i) { const int t = crow(i, hh) + 32 * tb;
                if (t < nvalid) { const float sc = rs[t]; bf16* mp = mix + (size_t)(tok0 + t) * DM + 512 + h * 64 + r;
                    mp[0] = (bf16)(pk2(acc[tb][0][i] * sc * g0, 0.f) & 0xffffu); mp[32] = (bf16)(pk2(acc[tb][1][i] * sc * g1, 0.f) & 0xffffu); } }
        __syncthreads();
    }
}

NOINL void phase_scan(PARAMS_T p) {
    const int gid = blockIdx.x * 512 + threadIdx.x;
    if (gid < NBP * NH * 1024) {
        const int bh = gid >> 10, e4 = gid & 1023, b = bh >> 3, h = bh & 7;
        float* st = (float*)(p.ws + WS_ST); const float* dec = (const float*)(p.ws + WS_DEC);
        f32x4 hs = {0.f, 0.f, 0.f, 0.f};
#pragma unroll
        for (int c0 = 0; c0 < NCH; c0 += 16) {
            f32x4 tv[16]; float dv[16];
#pragma unroll
            for (int c = 0; c < 16; ++c) { tv[c] = *((const f32x4*)(st + (size_t)((b * NCH + c0 + c) * NH + h) * 4096) + e4); dv[c] = dec[(b * NCH + c0 + c) * NH + h]; }
#pragma unroll
            for (int c = 0; c < 16; ++c) { *((f32x4*)(st + (size_t)((b * NCH + c0 + c) * NH + h) * 4096) + e4) = hs; hs = hs * dv[c] + tv[c]; }
        }
        *((f32x4*)(p.out + O_HP + (size_t)bh * 4096) + e4) = hs;
    }
}
NOINL void phase_post_mixer(PARAMS_T p) {
    const int lane = threadIdx.x & 63, gw = blockIdx.x * 8 + (threadIdx.x >> 6), NGW = gridDim.x * 8;
    f32x4 g1[4], g2[4];
#pragma unroll
    for (int j = 0; j < 4; ++j) { g1[j] = *(const f32x4*)(p.in[8] + 4 * lane + 256 * j); g2[j] = *(const f32x4*)(p.in[18] + 4 * lane + 256 * j); }
    for (int row = gw; row < MT; row += NGW) {
        const float* xr = (row < MP) ? p.in[0] + (size_t)row * DM : p.in[1] + (size_t)(row - MP) * DM;
        f32x4 m[4], x[4]; float s = 0.f;
        if (row >= MP) {
#pragma unroll
            for (int j = 0; j < 4; ++j) { m[j] = (f32x4){0.f, 0.f, 0.f, 0.f};
#pragma unroll
                for (int ks = 0; ks < KS_OUT; ++ks) m[j] += *(const f32x4*)((const float*)(p.ws + WS_MS) + ((size_t)ks * MS + (row - MP)) * DM + 4 * lane + 256 * j); }
        } else {
#pragma unroll
            for (int j = 0; j < 4; ++j) { const u32x2 t = *(const u32x2*)((const bf16*)(p.ws + WS_M) + (size_t)row * DM + 4 * lane + 256 * j); m[j] = (f32x4){bflo(t.x), bfhi(t.x), bflo(t.y), bfhi(t.y)}; }
        }
#pragma unroll
        for (int j = 0; j < 4; ++j) { x[j] = *(const f32x4*)(xr + 4 * lane + 256 * j); s += (m[j].x * m[j].x + m[j].y * m[j].y) + (m[j].z * m[j].z + m[j].w * m[j].w); }
        const float r1 = __builtin_amdgcn_rsqf(wave_sum(s) * (1.f / DM) + EPS); float s2 = 0.f;
        float* hr = p.out + (size_t)row * DM;
#pragma unroll
        for (int j = 0; j < 4; ++j) { x[j] = x[j] + m[j] * r1 * g1[j]; *(f32x4*)(hr + 4 * lane + 256 * j) = x[j]; s2 += (x[j].x * x[j].x + x[j].y * x[j].y) + (x[j].z * x[j].z + x[j].w * x[j].w); }
        const float r2 = __builtin_amdgcn_rsqf(wave_sum(s2) * (1.f / DM) + EPS);
        bf16* orow = (bf16*)(p.ws + WS_A16) + (size_t)row * DM;
#pragma unroll
        for (int j = 0; j < 4; ++j) { const f32x4 v = x[j] * r2 * g2[j]; u32x2 o = {pk2(v.x, v.y), pk2(v.z, v.w)}; *(u32x2*)(orow + 4 * lane + 256 * j) = o; }
    }
}
NOINL void phase_final(PARAMS_T p) {
    const int lane = threadIdx.x & 63, gw = blockIdx.x * 8 + (threadIdx.x >> 6), NGW = gridDim.x * 8;
    f32x4 g1[4];
#pragma unroll
    for (int j = 0; j < 4; ++j) g1[j] = *(const f32x4*)(p.in[19] + 4 * lane + 256 * j);
    for (int row = gw; row < MT; row += NGW) {
        float* hr = p.out + (size_t)row * DM;
        f32x4 f[4], x[4]; float s = 0.f;
        if (row >= MP) {
#pragma unroll
            for (int j = 0; j < 4; ++j) { f[j] = (f32x4){0.f, 0.f, 0.f, 0.f};
#pragma unroll
                for (int ks = 0; ks < KS_DN; ++ks) f[j] += *(const f32x4*)((const float*)(p.ws + WS_FS) + ((size_t)ks * MS + (row - MP)) * DM + 4 * lane + 256 * j); }
        } else {
#pragma unroll
            for (int j = 0; j < 4; ++j) { const u32x2 t = *(const u32x2*)((const bf16*)(p.ws + WS_F) + (size_t)row * DM + 4 * lane + 256 * j); f[j] = (f32x4){bflo(t.x), bfhi(t.x), bflo(t.y), bfhi(t.y)}; }
        }
#pragma unroll
        for (int j = 0; j < 4; ++j) { x[j] = *(const f32x4*)(hr + 4 * lane + 256 * j); s += (f[j].x * f[j].x + f[j].y * f[j].y) + (f[j].z * f[j].z + f[j].w * f[j].w); }
        const float r1 = __builtin_amdgcn_rsqf(wave_sum(s) * (1.f / DM) + EPS);
#pragma unroll
        for (int j = 0; j < 4; ++j) *(f32x4*)(hr + 4 * lane + 256 * j) = x[j] + f[j] * r1 * g1[j];
    }
}
DI void unpack8(const u32x4 v, float (&f)[8]) { f[0] = bflo(v.x); f[1] = bfhi(v.x); f[2] = bflo(v.y); f[3] = bfhi(v.y); f[4] = bflo(v.z); f[5] = bfhi(v.z); f[6] = bflo(v.w); f[7] = bfhi(v.w); }
NOINL void phase_act(PARAMS_T p) {
    const bf16* G = (const bf16*)(p.ws + WS_G); bf16* U = (bf16*)(p.ws + WS_U);
    const float* cw = p.in[21]; const float* cb = p.in[22];
    const int total = gridDim.x * 512;
    for (int task = blockIdx.x * 512 + threadIdx.x; task < (MT / 32) * (DFF / 8); task += total) {
        const int run = task / (DFF / 8), col = (task % (DFF / 8)) * 8, row0 = run * 32;
        float w0[8], w1[8], w2[8], bs[8], g2[8], g1[8];
#pragma unroll
        for (int j = 0; j < 8; ++j) { w0[j] = cw[col + j]; w1[j] = cw[DFF + col + j]; w2[j] = cw[2 * DFF + col + j]; bs[j] = cb[col + j]; g2[j] = 0.f; g1[j] = 0.f; }
        if (row0 >= MP) { const float* sp = p.in[6] + (size_t)((row0 - MP) >> 5) * 2 * DFF + col;
#pragma unroll
            for (int j = 0; j < 8; ++j) { g2[j] = sp[j]; g1[j] = sp[DFF + j]; } }
        else if (row0 & (LP - 1)) { unpack8(*(const u32x4*)(G + (size_t)(row0 - 2) * DFF + col), g2); unpack8(*(const u32x4*)(G + (size_t)(row0 - 1) * DFF + col), g1); }
#pragma unroll 4
        for (int t = 0; t < 32; ++t) {
            float g0[8], uu[8], a[8];
            unpack8(*(const u32x4*)(G + (size_t)(row0 + t) * DFF + col), g0); unpack8(*(const u32x4*)(U + (size_t)(row0 + t) * DFF + col), uu);
#pragma unroll
            for (int j = 0; j < 8; ++j) { a[j] = gelu_tanh_f(bs[j] + w0[j] * g2[j] + w1[j] * g1[j] + w2[j] * g0[j]) * uu[j]; g2[j] = g1[j]; g1[j] = g0[j]; }
            u32x4 o = {pk2(a[0], a[1]), pk2(a[2], a[3]), pk2(a[4], a[5]), pk2(a[6], a[7])};
            *(u32x4*)(U + (size_t)(row0 + t) * DFF + col) = o;
        }
    }
}

NOINL void gemm_inproj(PARAMS_T p, LAS unsigned char* lds) {
    const int G = gridDim.x, bx = blockIdx.x;
    pg8::Gemm g{(const pg8::bf16_t*)(p.ws + WS_A16), (const pg8::bf16_t*)(p.ws + WS_WIN), MT, NPROJ, DM, DM}; pg8::StaticOrder S; S.init(MT, NPROJ, G, bx);
    EpiInProj E{p.ws, p.out};
    pg8::gemm_phase<EpiInProj, pg8::StaticOrder, true, true>(lds, g, S, E);
}
NOINL void gemm_up(PARAMS_T p, LAS unsigned char* lds) {
    const int G = gridDim.x, bx = blockIdx.x;
    pg8::Gemm g{(const pg8::bf16_t*)(p.ws + WS_A16), (const pg8::bf16_t*)(p.ws + WS_WUP), MT, NUP, DM, DM}; pg8::StaticOrder S; S.init(MT, NUP, G, bx);
    EpiUpAct E{(bf16*)(p.ws + WS_U), p.out, (float*)(p.ws + WS_GH), (float*)(p.ws + WS_GF), (float*)(p.ws + WS_UF), p.in[21], p.in[22], p.in[6], (LAS float*)(lds + 131072)};
    pg8::gemm_phase<EpiUpAct, pg8::StaticOrder, true, true>(lds, g, S, E);
}
NOINL void gemm_n1024(PARAMS_T p, LAS unsigned char* lds, int which) {
    const int G = gridDim.x, bx = blockIdx.x;
    const pg8::bf16_t* A = (const pg8::bf16_t*)(p.ws + (which ? WS_U : WS_A16)); const pg8::bf16_t* Bt = (const pg8::bf16_t*)(p.ws + (which ? WS_WDN : WS_WOUT));
    const int K = which ? DFF : DM, nS = which ? KS_DN : KS_OUT;
    float* O0 = (float*)(p.ws + (which ? WS_F : WS_M)); float* O1 = (float*)(p.ws + (which ? WS_FS : WS_MS));
    if (which) {
        pg8::SplitOrder S0{0, MP / 256, DM / 256, 1, 256, G, bx}; pg8::Unit u;
        for (int i = 0; S0.next(i, u); ++i) ffn_fixup(p, u.pm);
        __syncthreads();
    }
#pragma unroll 1
    for (int call = 0; call < 2; ++call) {
        pg8::Gemm g{A, Bt, call ? MS : MP, DM, call ? 256 : K, K};
        pg8::SplitOrder S{call ? MP / 256 : 0, call ? MS / 256 : MP / 256, DM / 256, call ? nS : 1, 256, G, bx};
        EpiF32Split E{O1, call ? (bf16*)nullptr : (bf16*)O0};
        pg8::gemm_phase<EpiF32Split, pg8::SplitOrder, true, true>(lds, g, S, E);
    }
}

constexpr int N_PHASES = 12;
__global__ void __launch_bounds__(512, 2) fwd_kernel(Params p_arg) {
    extern __shared__ __attribute__((aligned(16))) unsigned char lds_raw[];
    LAS unsigned char* lds = (LAS unsigned char*)lds_raw;
    PARAMS_T p = *(const __attribute__((address_space(4))) Params*)__builtin_amdgcn_kernarg_segment_ptr();
    cg::grid_group grid = cg::this_grid();
    const int lo = p.ph_lo, hi = p.ph_hi;
#ifndef PH_MASK
#define PH_MASK 0xfff
#endif
#define IN(k) (((PH_MASK >> (k)) & 1) && lo <= (k) && (k) < hi)
#ifdef PROBE_A0
#define STAMP(i) do { if (bx == 0 && threadIdx.x == 0) ((LAS unsigned long long*)(lds + 144000))[i] = __builtin_amdgcn_s_memrealtime(); } while (0)
#else
#define STAMP(i) do { } while (0)
#endif
#define SEAM(k) do { if (IN(k) && IN((k) + 1)) xcd_barrier(bar); STAMP((k) + 1); } while (0)
    const int G = gridDim.x, bx = blockIdx.x;
    volatile LAS unsigned* bst = (volatile LAS unsigned*)(lds + 147000);
    if (threadIdx.x < 2) bst[threadIdx.x] = 0u;
    __syncthreads();
    XcdBarrier bar = xcd_barrier_post((unsigned*)p.ws, bst);
    if (hi > 1000) grid.sync();
    STAMP(0);
    if (IN(0)) phase_prologue(p, lds);
    SEAM(0);
    if (IN(1)) gemm_inproj(p, lds);
    SEAM(1);
    if (IN(2)) {
        for (int it = bx; it < NCHUNK; it += G) { conv_chunk(p, it); __threadfence_block(); __syncthreads(); ssd_item<false>(p, it, lds); if (it >= NBP * NCH) ssd_item<true>(p, it, lds); }
        for (int it = bx; it < NBP * (LP / 32); it += G) attn_item<false>(p, it & 7, 63 - (it >> 3), lds);
        if (bx >= 128 && bx < 128 + NBS) attn_item<true>(p, bx - 128, 0, lds);
    }
    SEAM(2);
    if (IN(4)) phase_scan(p);
    SEAM(4);
    if (IN(5)) { for (int it = bx; it < NBP * NCH; it += G) ssd_item<true>(p, it, lds); }
    SEAM(5);
    if (IN(6)) gemm_n1024(p, lds, 0);
    SEAM(6);
    if (IN(7)) phase_post_mixer(p);
    SEAM(7);
    if (IN(8)) gemm_up(p, lds);
    if (IN(8) && IN(10)) xcd_barrier(bar);
    STAMP(9);
    if (IN(10)) gemm_n1024(p, lds, 1);
    SEAM(10);
    if (IN(11)) phase_final(p);
#ifdef PROBE_A0
    if (bx == 0) {
        __syncthreads();
        if (threadIdx.x == 0) ((LAS unsigned long long*)(lds + 144000))[12] = __builtin_amdgcn_s_memrealtime();
        __syncthreads();
        const LAS unsigned long long* ts = (const LAS unsigned long long*)(lds + 144000);
        const float ta = (float)(long long)(ts[PROBE_A1] - ts[PROBE_A0]) * 0.01f, tb = (float)(long long)(ts[PROBE_B1] - ts[PROBE_B0]) * 0.01f;
        if (threadIdx.x == 0) p.out[O_KP] += ta * 0.0005f;
        const float eps1 = 1.f + sqrtf(tb * (PROBE_BS) * 1e-6f);
        for (int i = threadIdx.x; i < NBS * 3 * CONVD; i += 512) p.out[O_CSS + i] *= eps1;
    }
#endif
#undef IN
#undef SEAM
}

#ifndef N_LAUNCHES
#define N_LAUNCHES 1
#endif
extern "C" void kernel_launch(void* const* d_in, const int* in_sizes, int n_in, void* d_out, int out_size, void* d_ws, size_t ws_size, hipStream_t stream) {
    static int grid = 0;
    if (grid == 0) {
        if (n_in != 24 || out_size != (int)O_END || ws_size < WS_NEED) { fprintf(stderr, "kernel_launch: unexpected shapes: n_in %d out %d ws %zu\n", n_in, out_size, ws_size); grid = -1; return; }
        int dev = 0, cus = 0, per_cu = 0;
        (void)hipGetDevice(&dev); (void)hipDeviceGetAttribute(&cus, hipDeviceAttributeMultiprocessorCount, dev);
        if (hipFuncSetAttribute((const void*)fwd_kernel, hipFuncAttributeMaxDynamicSharedMemorySize, LDS_BYTES) != hipSuccess) { fprintf(stderr, "kernel_launch: hipFuncSetAttribute failed\n"); grid = -1; return; }
        if (hipOccupancyMaxActiveBlocksPerMultiprocessor(&per_cu, (const void*)fwd_kernel, 512, LDS_BYTES) != hipSuccess || per_cu < 1) { fprintf(stderr, "kernel_launch: occupancy query says %d\n", per_cu); per_cu = 1; }
        (void)hipGetLastError();
        grid = cus * (per_cu > 1 ? 1 : per_cu);
        if (grid <= 0) grid = 256;
    }
    if (grid < 0) return;
    if (hipMemsetAsync(d_ws, 0, 16384, stream) != hipSuccess) { fprintf(stderr, "kernel_launch: memset failed\n"); return; }
    Params p{};
    for (int i = 0; i < 24; ++i) p.in[i] = (const float*)d_in[i];
    p.out = (float*)d_out; p.ws = (unsigned char*)d_ws;
#if N_LAUNCHES == 1
    p.ph_lo = 0; p.ph_hi = N_PHASES;
    void* args[] = {&p};
    hipError_t e = hipLaunchCooperativeKernel((const void*)fwd_kernel, dim3(grid), dim3(512), args, LDS_BYTES, stream);
    if (e != hipSuccess) fprintf(stderr, "cooperative launch failed: %s (grid %d)\n", hipGetErrorString(e), grid);
#else
    for (int k = 0; k < N_PHASES; ++k) { p.ph_lo = k; p.ph_hi = k + 1; hipLaunchKernelGGL(fwd_kernel, dim3(grid), dim3(512), LDS_BYTES, stream, p); }
#endif
}
```
